# Optimizing an MI355X kernel written in HIP

```python
import math
import jax, jax.numpy as jnp
from jax import lax
import numpy as np

D_MODEL = 2048
BATCH = 4
SEQ = 4096
DEPTH = 2

EXPAND = 2
D_INNER = EXPAND * D_MODEL
HEAD_DIM = 128
N_HEADS_SB = (D_INNER // 2) // HEAD_DIM
N_HEADS_DIL = (D_INNER // 2) // HEAD_DIM
D_SB = N_HEADS_SB * HEAD_DIM
D_DIL = N_HEADS_DIL * HEAD_DIM
DILATED_GROUPS = ((128, 1), (512, 4), (2048, 16))
SB_BLOCK = 128
N_HEADS_HGRN = D_INNER // HEAD_DIM
HGRN_CHUNK = 32
N_EVEN = (DEPTH + 1) // 2
N_ODD = DEPTH // 2
EVEN_IN_COLS = 3 * D_SB + 3 * D_DIL + D_INNER
ODD_IN_COLS = 4 * D_INNER
RMS_EPS = 1e-6

kernel_name = "hybrid_stickbreak_dilated_hgrn2"


def rms_norm(x, gain):
    xf = x.astype(jnp.float32)
    y = xf * lax.rsqrt(jnp.mean(xf * xf, axis=-1, keepdims=True) + RMS_EPS)
    return (y * gain.astype(jnp.float32)).astype(x.dtype)


def split_cols(t, sizes):
    idx = [int(c) for c in np.cumsum(sizes)[:-1]]
    return jnp.split(t, idx, axis=-1)


def to_heads(t):
    b, s, _ = t.shape
    return t.reshape(b, s, -1, HEAD_DIM)


def stick_breaking_attention(q, k, v):
    b, s_len, h, dh = q.shape
    scale = 1.0 / math.sqrt(dh)
    qf = q.astype(jnp.float32).transpose(0, 2, 1, 3)
    kf = k.astype(jnp.float32).transpose(0, 2, 1, 3)
    vf = v.astype(jnp.float32).transpose(0, 2, 1, 3)
    outs = []
    for blk in range(s_len // SB_BLOCK):
        q0 = blk * SB_BLOCK
        kend = q0 + SB_BLOCK
        z = jnp.einsum('bhqd,bhkd->bhqk', qf[:, :, q0:kend], kf[:, :, :kend]) * scale
        t_pos = q0 + jnp.arange(SB_BLOCK)[:, None]
        s_pos = jnp.arange(kend)[None, :]
        mask = s_pos < t_pos
        log_1m = jnp.where(mask, jax.nn.log_sigmoid(-z), 0.0)
        tail = lax.cumsum(log_1m, axis=3, reverse=True) - log_1m
        a = jnp.where(mask, jnp.exp(jax.nn.log_sigmoid(z) + tail), 0.0)
        outs.append(jnp.einsum('bhqk,bhkd->bhqd', a, vf[:, :, :kend]))
    return jnp.concatenate(outs, axis=2).transpose(0, 2, 1, 3)


def dilated_branch(q, k, v, window, dilation):
    b, s_len, h, dh = q.shape
    scale = 1.0 / math.sqrt(dh)
    blk = window // dilation
    L = s_len // dilation
    nblk = -(-L // blk)
    Lp = nblk * blk

    def to_blocks(t):
        t = t.reshape(b, L, dilation, h, dh).transpose(0, 2, 1, 3, 4)
        t = jnp.pad(t, ((0, 0), (0, 0), (0, Lp - L), (0, 0), (0, 0)))
        return t.reshape(b, dilation, nblk, blk, h, dh)

    def with_prev(t):
        prev = jnp.pad(t, ((0, 0), (0, 0), (1, 0), (0, 0), (0, 0), (0, 0)))[:, :, :-1]
        return jnp.concatenate([prev, t], axis=3)

    qb = to_blocks(q)
    kc = with_prev(to_blocks(k))
    vc = with_prev(to_blocks(v))
    sc = jnp.einsum('bpnqhd,bpnkhd->bpnhqk', qb, kc) * scale
    n_i = jnp.arange(nblk)[:, None, None]
    q_i = jnp.arange(blk)[None, :, None]
    k_j = jnp.arange(2 * blk)[None, None, :]
    dist = blk + q_i - k_j
    valid = (dist >= 0) & (dist <= blk) & ((n_i > 0) | (k_j >= blk))
    sc = jnp.where(valid[:, None], sc, -jnp.inf)
    lse = jax.nn.logsumexp(sc, axis=-1)
    p = jnp.exp(sc - lse[..., None])
    o = jnp.einsum('bpnhqk,bpnkhd->bpnqhd', p, vc)
    o = o.reshape(b, dilation, Lp, h, dh)[:, :, :L].transpose(0, 2, 1, 3, 4).reshape(b, s_len, h, dh)
    lse = lse.transpose(0, 1, 2, 4, 3).reshape(b, dilation, Lp, h)[:, :, :L]
    lse = lse.transpose(0, 2, 1, 3).reshape(b, s_len, h)
    return o, lse


def dilated_attention(q, k, v, q_gain, k_gain):
    qf = rms_norm(q.astype(jnp.float32), q_gain)
    kf = rms_norm(k.astype(jnp.float32), k_gain)
    vf = v.astype(jnp.float32)
    outs, lses = [], []
    for window, dilation in DILATED_GROUPS:
        o, lse = dilated_branch(qf, kf, vf, window, dilation)
        outs.append(o)
        lses.append(lse)
    wts = jax.nn.softmax(jnp.stack(lses, axis=0), axis=0)
    return jnp.sum(wts[..., None] * jnp.stack(outs, axis=0), axis=0)


def hgrn2(q, f_pre, inp, lb):
    b, s_len, h, d = q.shape
    lb = lb.reshape(h, d)
    fp = f_pre.astype(jnp.float32)
    log_f = jnp.logaddexp(jnp.log(lb), jnp.log1p(-lb) + jax.nn.log_sigmoid(fp))
    key = (1.0 - lb) * jax.nn.sigmoid(-fp)
    n_c = s_len // HGRN_CHUNK

    def chunks(t):
        return t.astype(jnp.float32).reshape(b, n_c, HGRN_CHUNK, h, d).transpose(1, 0, 3, 2, 4)

    causal = jnp.arange(HGRN_CHUNK)[:, None] >= jnp.arange(HGRN_CHUNK)[None, :]

    def step(state, xs):
        qc, kc, vc, gc = xs
        cum = jnp.cumsum(gc, axis=2)
        inter = jnp.einsum('bhtc,bhcv->bhtv', qc * jnp.exp(cum), state)
        diff = cum[:, :, :, None, :] - cum[:, :, None, :, :]
        decay = jnp.exp(jnp.where(causal[:, :, None], diff, -jnp.inf))
        attn = jnp.einsum('bhtc,bhsc,bhtsc->bhts', qc, kc, decay)
        intra = jnp.einsum('bhts,bhsv->bhtv', attn, vc)
        last = cum[:, :, -1:, :]
        new_state = jnp.exp(last[:, :, 0, :])[..., None] * state + jnp.einsum(
            'bhsc,bhsv->bhcv', kc * jnp.exp(last - cum), vc)
        return new_state, inter + intra

    init = jnp.zeros((b, h, d, d), jnp.float32)
    _, ys = lax.scan(step, init, (chunks(q), chunks(key), chunks(inp), chunks(log_f)))
    return ys.transpose(1, 0, 3, 2, 4).reshape(b, s_len, h, d)


def even_layer(x, norm_g, w_in, q_gain, k_gain, w_out):
    b, s_len, _ = x.shape
    hdn = rms_norm(x, norm_g)
    proj = jnp.einsum('bsd,de->bse', hdn, w_in)
    qa, ka, va, qb, kb, vb, gate = split_cols(
        proj, [D_SB, D_SB, D_SB, D_DIL, D_DIL, D_DIL, D_INNER])
    oa = stick_breaking_attention(to_heads(qa), to_heads(ka), to_heads(va))
    ob = dilated_attention(to_heads(qb), to_heads(kb), to_heads(vb), q_gain, k_gain)
    mix = jnp.concatenate([oa.reshape(b, s_len, D_SB), ob.reshape(b, s_len, D_DIL)], axis=-1)
    mix = mix * jax.nn.silu(gate.astype(jnp.float32))
    return x + jnp.einsum('bse,ed->bsd', mix.astype(x.dtype), w_out)


def odd_layer(x, norm_g, w_in, lb, o_gain, w_out):
    b, s_len, _ = x.shape
    hdn = rms_norm(x, norm_g)
    proj = jnp.einsum('bsd,de->bse', hdn, w_in)
    q, f_pre, inp, gate = split_cols(proj, [D_INNER, D_INNER, D_INNER, D_INNER])
    o = hgrn2(to_heads(q), to_heads(f_pre), to_heads(inp), lb)
    o = rms_norm(o, o_gain).reshape(b, s_len, D_INNER)
    mix = o * jax.nn.silu(gate.astype(jnp.float32))
    return x + jnp.einsum('bse,ed->bsd', mix.astype(x.dtype), w_out)


def setup_inputs(seed: int = 0) -> dict:
    key = jax.random.key(seed)
    ks = jax.random.split(key, 12)
    f32 = jnp.float32
    x = jax.random.normal(ks[0], (BATCH, SEQ, D_MODEL), f32)
    norm_even = 1.0 + 0.02 * jax.random.normal(ks[1], (N_EVEN, D_MODEL), f32)
    w_in_even = jax.random.normal(ks[2], (N_EVEN, D_MODEL, EVEN_IN_COLS), f32) * D_MODEL ** -0.5
    q_norm_even = 1.0 + 0.02 * jax.random.normal(ks[3], (N_EVEN, HEAD_DIM), f32)
    k_norm_even = 1.0 + 0.02 * jax.random.normal(ks[4], (N_EVEN, HEAD_DIM), f32)
    w_out_even = jax.random.normal(ks[5], (N_EVEN, D_INNER, D_MODEL), f32) * D_INNER ** -0.5
    norm_odd = 1.0 + 0.02 * jax.random.normal(ks[6], (N_ODD, D_MODEL), f32)
    w_in_odd = jax.random.normal(ks[7], (N_ODD, D_MODEL, ODD_IN_COLS), f32) * D_MODEL ** -0.5
    lb_logits = 0.1 * jax.random.normal(ks[8], (DEPTH, D_INNER), f32)
    o_norm_odd = 1.0 + 0.02 * jax.random.normal(ks[9], (N_ODD, HEAD_DIM), f32)
    w_out_odd = jax.random.normal(ks[10], (N_ODD, D_INNER, D_MODEL), f32) * D_INNER ** -0.5
    return {"x": x, "norm_even": norm_even, "w_in_even": w_in_even,
            "q_norm_even": q_norm_even, "k_norm_even": k_norm_even, "w_out_even": w_out_even,
            "norm_odd": norm_odd, "w_in_odd": w_in_odd, "lb_logits": lb_logits,
            "o_norm_odd": o_norm_odd, "w_out_odd": w_out_odd}


def reference(x, norm_even, w_in_even, q_norm_even, k_norm_even, w_out_even,
              norm_odd, w_in_odd, lb_logits, o_norm_odd, w_out_odd):
    p = jax.nn.softmax(lb_logits.astype(jnp.float32), axis=0)
    lb_all = jnp.cumsum(p, axis=0) - p[0:1]
    for layer in range(DEPTH):
        j = layer // 2
        if layer % 2 == 0:
            x = even_layer(x, norm_even[j], w_in_even[j], q_norm_even[j], k_norm_even[j], w_out_even[j])
        else:
            x = odd_layer(x, norm_odd[j], w_in_odd[j], lb_all[layer], o_norm_odd[j], w_out_odd[j])
    return x
```

```cpp
#include <hip/hip_runtime.h>
#include <hip/hip_cooperative_groups.h>
#include <cstdio>
namespace cg = cooperative_groups;

#define LAS __attribute__((address_space(3)))
typedef unsigned short bf16_t;
typedef short bf16x8 __attribute__((ext_vector_type(8)));
typedef short s16x4 __attribute__((ext_vector_type(4)));
typedef float f32x4 __attribute__((ext_vector_type(4)));
typedef float f32x2_t __attribute__((ext_vector_type(2)));
typedef __bf16 bf16x2_t __attribute__((ext_vector_type(2)));
typedef unsigned u32x4 __attribute__((ext_vector_type(4)));
typedef unsigned u32x2 __attribute__((ext_vector_type(2)));

constexpr int SEQ = 4096, DM = 2048, NC = 16384, DI = 4096, MTOK = 16384, MH = 8192;
constexpr float RMS_EPS = 1e-6f;
constexpr size_t MiB = 1u << 20;
constexpr size_t WS_WIN = 1 * MiB, WS_WO = 65 * MiB, WS_XN = 81 * MiB, WS_PJ = 145 * MiB, WS_OG = 401 * MiB, WS_LSE = 497 * MiB, WS_END = 499 * MiB;
constexpr int LDS_BYTES = 147456;

__device__ __forceinline__ unsigned cvtpk(float lo, float hi) { f32x2_t v = {lo, hi}; bf16x2_t b = __builtin_convertvector(v, bf16x2_t); return __builtin_bit_cast(unsigned, b); }
__device__ __forceinline__ float bflo(unsigned w) { return __uint_as_float(w << 16); }
__device__ __forceinline__ float bfhi(unsigned w) { return __uint_as_float(w & 0xffff0000u); }
__device__ __forceinline__ void unpack8(const u32x4 w, float* f) { f[0] = bflo(w.x); f[1] = bfhi(w.x); f[2] = bflo(w.y); f[3] = bfhi(w.y); f[4] = bflo(w.z); f[5] = bfhi(w.z); f[6] = bflo(w.w); f[7] = bfhi(w.w); }
__device__ __forceinline__ u32x4 pack8(const float* f) { u32x4 w; w.x = cvtpk(f[0], f[1]); w.y = cvtpk(f[2], f[3]); w.z = cvtpk(f[4], f[5]); w.w = cvtpk(f[6], f[7]); return w; }
__device__ __forceinline__ float silu_f(float g) { return g / (1.0f + __expf(-g)); }
__device__ __forceinline__ float softplus_f(float z) { return fmaxf(z, 0.f) + __logf(1.0f + __expf(-fabsf(z))); }

__device__ __forceinline__ int opaque_tid() { int t = threadIdx.x; asm volatile("" : "+v"(t)); return t; }

__device__ __forceinline__ bf16x8 frag_row(LAS const unsigned char* tile, int stride, int r0, int k0, int lane) {
    return *(LAS const bf16x8*)(tile + (r0 + (lane & 15)) * stride + (k0 + 8 * (lane >> 4)) * 2);
}
__device__ __forceinline__ s16x4 tr4(LAS const unsigned char* p) { return __builtin_bit_cast(s16x4, __builtin_amdgcn_ds_read_tr16_b64_v4i16((LAS s16x4*)p)); }
__device__ __forceinline__ bf16x8 frag_tr(LAS const unsigned char* tile, int stride, int k0, int n0, int lane) {
    const int g = lane >> 4, q = (lane & 15) >> 2, p = lane & 3;
    LAS const unsigned char* a = tile + (k0 + 8 * g + q) * stride + (n0 + 4 * p) * 2;
    const s16x4 lo = tr4(a), hi = tr4(a + 4 * stride);
    return (bf16x8){lo[0], lo[1], lo[2], lo[3], hi[0], hi[1], hi[2], hi[3]};
}
__device__ __forceinline__ bf16x8 frag_tr_alt(LAS const unsigned char* tile, int stride, int k0, int n0, int lane) {
    const int g = lane >> 4, q = (lane & 15) >> 2, p = lane & 3;
    LAS const unsigned char* a = tile + (k0 + 4 * g + q) * stride + (n0 + 4 * p) * 2;
    const s16x4 lo = tr4(a), hi = tr4(a + 16 * stride);
    return (bf16x8){lo[0], lo[1], lo[2], lo[3], hi[0], hi[1], hi[2], hi[3]};
}
__device__ __forceinline__ f32x4 mma(bf16x8 a, bf16x8 b, f32x4 c) { return __builtin_amdgcn_mfma_f32_16x16x32_bf16(a, b, c, 0, 0, 0); }
__device__ __forceinline__ bf16x8 pack_frag(const f32x4 lo, const f32x4 hi) {
    u32x4 w; w.x = cvtpk(lo[0], lo[1]); w.y = cvtpk(lo[2], lo[3]); w.z = cvtpk(hi[0], hi[1]); w.w = cvtpk(hi[2], hi[3]);
    return __builtin_bit_cast(bf16x8, w);
}

namespace pg8 {
constexpr int BM = 256, BK = 64, HALF = 128, HTB = HALF * BK * 2, STAGE_BYTES = 8 * HTB, NXCD = 8, WGM = 8;
__device__ __forceinline__ int lds_byte(int r, int c) { const int st = (r >> 4) * 2 + (c >> 5), rr = r & 15, cc = c & 31, ob = rr * 64 + cc * 2; return st * 1024 + (ob ^ (((ob >> 9) & 1) << 5)); }
__device__ __forceinline__ void stage_rc(int b, int& R, int& C) { const int st = b / 1024, sb = b % 1024, swz = sb ^ (((sb >> 9) & 1) << 5); R = (st >> 1) * 16 + swz / 64; C = (st & 1) * 32 + (swz % 64) / 2; }
__device__ __forceinline__ int perm32(int rho) { const int n = rho >> 4, i = rho & 15; return 8 * (i >> 2) + 4 * n + (i & 3); }
struct Unit { int pm, pn; };
struct Gemm { const bf16_t* A; const bf16_t* Bt; int M, N, K, lda; };
struct StaticOrder {
    int nM, nN, nwg, G, c;
    __device__ void init(int M, int N, int G_, int c_) { nM = M / BM; nN = N / BM; nwg = nM * nN; G = G_; c = c_; }
    __device__ bool next(int i, Unit& u) const {
        const long L = (long)i * G + c; if (L >= nwg) return false;
        int wgid = (int)L; { const int q = nwg / NXCD, r = nwg % NXCD, xcd = wgid % NXCD, off = wgid / NXCD; wgid = (xcd < r ? xcd * (q + 1) : r * (q + 1) + (xcd - r) * q) + off; }
        const int nig = WGM * nN, gid = wgid / nig, fm = gid * WGM, gsz = (nM - fm) < WGM ? (nM - fm) : WGM;
        u.pm = fm + ((wgid % nig) % gsz); u.pn = (wgid % nig) / gsz; return true;
    }
};
struct EpiBf16 {
    static constexpr bool PERM = true;
    bf16_t* O; int ldc;
    __device__ __forceinline__ void operator()(const f32x4 (&acc)[2][2][4][2], const Unit& u, int wr, int wc, int fr, int fq) const {
        const int row0 = u.pm * BM + wr * 64 + fr, col0 = u.pn * BM + wc * 32 + 8 * fq;
#pragma unroll
        for (int ai = 0; ai < 2; ++ai)
#pragma unroll
            for (int m = 0; m < 4; ++m) { bf16_t* rowp = O + (size_t)(row0 + ai * HALF + m * 16) * ldc + col0;
#pragma unroll
                for (int bj = 0; bj < 2; ++bj) { const f32x4 v0 = acc[ai][bj][m][0], v1 = acc[ai][bj][m][1];
                    u32x4 w; w.x = cvtpk(v0[0], v0[1]); w.y = cvtpk(v0[2], v0[3]); w.z = cvtpk(v1[0], v1[1]); w.w = cvtpk(v1[2], v1[3]);
                    *(u32x4*)(rowp + bj * HALF) = w; } }
    }
};
struct EpiRes {
    static constexpr bool PERM = false;
    const float* R; float* C; int ldc;
    __device__ __forceinline__ void operator()(const f32x4 (&acc)[2][2][4][2], const Unit& u, int wr, int wc, int fr, int fq) const {
        const int row0 = u.pm * BM + wr * 64 + fr, col0 = u.pn * BM + wc * 32 + 4 * fq;
#pragma unroll
        for (int ai = 0; ai < 2; ++ai)
#pragma unroll
            for (int m = 0; m < 4; ++m) { const size_t ro = (size_t)(row0 + ai * HALF + m * 16) * ldc + col0;
#pragma unroll
                for (int bj = 0; bj < 2; ++bj)
#pragma unroll
                    for (int n = 0; n < 2; ++n) { const f32x4 r = *(const f32x4*)(R + ro + bj * HALF + n * 16); *(f32x4*)(C + ro + bj * HALF + n * 16) = acc[ai][bj][m][n] + r; } }
    }
};

template <class Epi>
__device__ __forceinline__ void gemm_phase(LAS unsigned char* lds, const Gemm g, const StaticOrder& S, const Epi& E) {
    const int tid = opaque_tid(), wid = __builtin_amdgcn_readfirstlane(tid >> 6), lane = tid & 63, wr = wid >> 2, wc = wid & 3, fr = lane & 15, fq = lane >> 4;
    const int K = g.K, nt = K / BK, lda = g.lda;
    unsigned voffA[2], voffB[2];
#pragma unroll
    for (int i = 0; i < 2; ++i) { int R, C; stage_rc(tid * 16 + i * 8192, R, C); const int Rb = Epi::PERM ? ((R & ~31) + perm32(R & 31)) : R;
        voffA[i] = (unsigned)(R * lda + C) * 2u; voffB[i] = (unsigned)(Rb * K + C) * 2u; }
    const size_t kstep = (size_t)(BK * 2);
    const size_t hstepA = (size_t)HALF * lda * 2, hstepB = (size_t)HALF * K * 2;
    const size_t tstepA = 2 * hstepA, tstepB = 2 * hstepB;
    const unsigned ldsw = (unsigned)wid * 1024u;
    const int aoff = lds_byte(wr * 64 + fr, fq * 8), boff = lds_byte(wc * 32 + fr, fq * 8);
#define PG8_SA(b, h) (((b) * 2 + (h)) * HTB)
#define PG8_SB(b, h) ((4 + (b) * 2 + (h)) * HTB)
#define PG8_STAGE(bufoff, gbase, voff) do { _Pragma("unroll") for (int _i = 0; _i < 2; ++_i) \
        __builtin_amdgcn_global_load_lds((const unsigned*)((const char*)(gbase) + (voff)[_i]), (LAS unsigned*)(lds + (bufoff) + ldsw + _i * 8192), 16, 0, 0); } while (0)
#define PG8_LDA(dst, b, h) do { _Pragma("unroll") for (int m = 0; m < 4; ++m) _Pragma("unroll") for (int k = 0; k < 2; ++k) dst[m][k] = *(const LAS bf16x8*)(lds + PG8_SA(b, h) + aoff + m * 2048 + k * 1024); } while (0)
#define PG8_LDB(dst, b, h) do { _Pragma("unroll") for (int n = 0; n < 2; ++n) _Pragma("unroll") for (int k = 0; k < 2; ++k) dst[n][k] = *(const LAS bf16x8*)(lds + PG8_SB(b, h) + boff + n * 2048 + k * 1024); } while (0)
#define PG8_MMA(ai, bj, At, Bt) do { __builtin_amdgcn_s_setprio(1); _Pragma("unroll") for (int m = 0; m < 4; ++m) _Pragma("unroll") for (int n = 0; n < 2; ++n) _Pragma("unroll") for (int k = 0; k < 2; ++k) \
        acc[ai][bj][m][n] = __builtin_amdgcn_mfma_f32_16x16x32_bf16(Bt[n][k], At[m][k], acc[ai][bj][m][n], 0, 0, 0); __builtin_amdgcn_s_setprio(0); } while (0)
#define PG8_WAIT_V(n) asm volatile("s_waitcnt vmcnt(" #n ")" ::: "memory")
#define PG8_WAIT_L(n) asm volatile("s_waitcnt lgkmcnt(" #n ")" ::: "memory")
#define PG8_BAR __builtin_amdgcn_s_barrier()
#define PG8_SCHED __builtin_amdgcn_sched_barrier(0)
    Unit cur, nxt; int ui = 0;
    if (!S.next(0, cur)) return;
    f32x4 acc[2][2][4][2];
#pragma unroll
    for (int a = 0; a < 2; ++a)
#pragma unroll
        for (int b = 0; b < 2; ++b)
#pragma unroll
            for (int m = 0; m < 4; ++m)
#pragma unroll
                for (int n = 0; n < 2; ++n) acc[a][b][m][n] = (f32x4){0.f, 0.f, 0.f, 0.f};
    bf16x8 At[4][2], B0[2][2], B1[2][2];
    const char* cA = (const char*)g.A + (size_t)cur.pm * tstepA; const char* cB = (const char*)g.Bt + (size_t)cur.pn * tstepB;
    PG8_STAGE(PG8_SB(0, 0), cB, voffB); PG8_STAGE(PG8_SA(0, 0), cA, voffA); PG8_STAGE(PG8_SB(0, 1), cB + hstepB, voffB); PG8_STAGE(PG8_SA(0, 1), cA + hstepA, voffA);
    if (wr == 1) PG8_BAR;
    PG8_WAIT_V(4); PG8_BAR;
    PG8_STAGE(PG8_SB(1, 0), cB + kstep, voffB); PG8_STAGE(PG8_SA(1, 0), cA + kstep, voffA); PG8_STAGE(PG8_SB(1, 1), cB + hstepB + kstep, voffB);
    PG8_WAIT_V(6); PG8_BAR;
    for (;;) {
        const bool has_next = S.next(ui + 1, nxt);
        const char* nA = has_next ? (const char*)g.A + (size_t)nxt.pm * tstepA : cA; const char* nB = has_next ? (const char*)g.Bt + (size_t)nxt.pn * tstepB : cB;
        for (int t = 0; t < nt; t += 2) {
            const bool last = (t == nt - 2);
            const char* a1 = cA + (size_t)(t + 1) * kstep;
            const char* a2 = last ? nA : cA + (size_t)(t + 2) * kstep; const char* b2 = last ? nB : cB + (size_t)(t + 2) * kstep;
            const char* a3 = a2 + kstep; const char* b3 = b2 + kstep;
            PG8_LDB(B0, 0, 0); PG8_SCHED; PG8_LDA(At, 0, 0); PG8_STAGE(PG8_SA(1, 1), a1 + hstepA, voffA);
            PG8_WAIT_L(8); PG8_BAR; PG8_WAIT_L(0); PG8_MMA(0, 0, At, B0); PG8_BAR; PG8_SCHED;
            PG8_LDB(B1, 0, 1); PG8_STAGE(PG8_SB(0, 0), b2, voffB);
            PG8_BAR; PG8_WAIT_L(0); PG8_MMA(0, 1, At, B1); PG8_BAR;
            PG8_LDA(At, 0, 1); PG8_STAGE(PG8_SA(0, 0), a2, voffA);
            PG8_BAR; PG8_WAIT_L(0); PG8_MMA(1, 0, At, B0); PG8_BAR; PG8_SCHED;
            PG8_STAGE(PG8_SB(0, 1), b2 + hstepB, voffB);
            PG8_WAIT_V(6); PG8_BAR; PG8_MMA(1, 1, At, B1); PG8_BAR;
            PG8_LDB(B0, 1, 0); PG8_SCHED; PG8_LDA(At, 1, 0); PG8_STAGE(PG8_SA(0, 1), a2 + hstepA, voffA);
            PG8_WAIT_L(8); PG8_BAR; PG8_WAIT_L(0); PG8_MMA(0, 0, At, B0); PG8_BAR; PG8_SCHED;
            PG8_LDB(B1, 1, 1); PG8_STAGE(PG8_SB(1, 0), b3, voffB);
            PG8_BAR; PG8_WAIT_L(0); PG8_MMA(0, 1, At, B1); PG8_BAR;
            PG8_LDA(At, 1, 1); PG8_STAGE(PG8_SA(1, 0), a3, voffA);
            PG8_BAR; PG8_WAIT_L(0); PG8_MMA(1, 0, At, B0); PG8_BAR; PG8_SCHED;
            PG8_STAGE(PG8_SB(1, 1), b3 + hstepB, voffB);
            PG8_WAIT_V(6); PG8_BAR; PG8_MMA(1, 1, At, B1); PG8_BAR;
        }
        E(acc, cur, wr, wc, fr, fq);
        if (!has_next) break;
#pragma unroll
        for (int a = 0; a < 2; ++a)
#pragma unroll
            for (int b = 0; b < 2; ++b)
#pragma unroll
                for (int m = 0; m < 4; ++m)
#pragma unroll
                    for (int n = 0; n < 2; ++n) acc[a][b][m][n] = (f32x4){0.f, 0.f, 0.f, 0.f};
        cur = nxt; cA = nA; cB = nB; ++ui;
    }
    PG8_WAIT_V(0);
    if (wr == 0) PG8_BAR;
    PG8_BAR;
#undef PG8_SA
#undef PG8_SB
#undef PG8_STAGE
#undef PG8_LDA
#undef PG8_LDB
#undef PG8_MMA
#undef PG8_WAIT_V
#undef PG8_WAIT_L
#undef PG8_BAR
#undef PG8_SCHED
}
}

__device__ __forceinline__ float wave_sum(float v) {
#pragma unroll
    for (int o = 1; o < 64; o <<= 1) v += __shfl_xor(v, o);
    return v;
}
__device__ __forceinline__ void transpose_item(const float* __restrict__ W, int K, int N, bf16_t* __restrict__ WT, LAS float* scr, int item, int lane) {
    const int nblk = N / 32, kb = item / nblk, nb = item % nblk, k0 = 64 * kb, n0 = 32 * nb;
#pragma unroll 8
    for (int i = 0; i < 32; ++i) { const int kk = 2 * i + (lane >> 5); scr[kk * 33 + (lane & 31)] = W[(size_t)(k0 + kk) * N + n0 + (lane & 31)]; }
    asm volatile("s_waitcnt lgkmcnt(0)" ::: "memory");
    const int c = lane & 7;
#pragma unroll
    for (int j = 0; j < 4; ++j) { const int n = (lane >> 3) + 8 * j; const LAS float* s = scr + (8 * c) * 33 + n;
        u32x4 o; o.x = cvtpk(s[0 * 33], s[1 * 33]); o.y = cvtpk(s[2 * 33], s[3 * 33]); o.z = cvtpk(s[4 * 33], s[5 * 33]); o.w = cvtpk(s[6 * 33], s[7 * 33]);
        *(u32x4*)(WT + (size_t)(n0 + n) * K + k0 + 8 * c) = o; }
    asm volatile("s_waitcnt lgkmcnt(0)" ::: "memory");
}
__device__ __forceinline__ void rms_row_to_bf16(const float* xrow, const float* g, bf16_t* orow, int lane) {
    const f32x4* xr = (const f32x4*)xrow + lane; const f32x4* gr = (const f32x4*)g + lane;
    f32x4 v[8]; float s = 0.f;
#pragma unroll
    for (int j = 0; j < 8; ++j) { v[j] = xr[64 * j]; s += (v[j].x * v[j].x + v[j].y * v[j].y) + (v[j].z * v[j].z + v[j].w * v[j].w); }
    const float rstd = rsqrtf(wave_sum(s) * (1.f / DM) + RMS_EPS);
    u32x2* o8 = (u32x2*)orow + lane;
#pragma unroll
    for (int j = 0; j < 8; ++j) { const f32x4 gg = gr[64 * j]; u32x2 w; w.x = cvtpk(v[j].x * rstd * gg.x, v[j].y * rstd * gg.y); w.y = cvtpk(v[j].z * rstd * gg.z, v[j].w * rstd * gg.w); o8[64 * j] = w; }
}
__device__ __forceinline__ void prologue(LAS unsigned char* lds, const float* x, const float* ng, const float* w_in, const float* w_out, bf16_t* WinT, bf16_t* WoT, bf16_t* XN) {
    const int tid = opaque_tid(), lane = tid & 63, wave = tid >> 6;
    LAS float* scr = (LAS float*)(lds + wave * 16384);
    const int gw = blockIdx.x * 8 + wave, NGW = gridDim.x * 8;
    constexpr int I_IN = (DM / 64) * (NC / 32), I_OUT = (DI / 64) * (DM / 32);
    for (int it = gw; it < I_IN + I_OUT; it += NGW) {
        if (it < I_IN) transpose_item(w_in, DM, NC, WinT, scr, it, lane);
        else transpose_item(w_out, DI, DM, WoT, scr, it - I_IN, lane);
    }
    for (int m = gw; m < MTOK; m += NGW) rms_row_to_bf16(x + (size_t)m * DM, ng, XN + (size_t)m * DM, lane);
}

constexpr int KVS = 272;
constexpr int A_KOFF = 0, A_VOFF = 64 * KVS;
constexpr float SM_SCALE = 0.08838834764831845f;

template <bool SBM>
__device__ __forceinline__ void attn_item(LAS unsigned char* lds, bf16_t* PJ, int bl, int h, int qt_or_n, int r, int p, int g,
                                          const float* qg, const float* kg, bf16_t* OG, float* LSE) {
    constexpr int MB = SBM ? 2 : 1;
    const int tid = opaque_tid(), lane = tid & 63, w = __builtin_amdgcn_readfirstlane(tid >> 6), fr = lane & 15, fq = lane >> 4;
    const int qcol = SBM ? h * 128 : 6144 + h * 128, kcol = SBM ? 2048 + h * 128 : 8192 + h * 128, vcol = SBM ? 4096 + h * 128 : 10240 + h * 128;
    const size_t rowbase = (size_t)bl * SEQ;
    const int q0 = SBM ? qt_or_n * 256 + 32 * w : qt_or_n * 128 + 16 * w;
    bf16x8 qf[MB][4];
#pragma unroll
    for (int mb = 0; mb < MB; ++mb) {
        const int qi = q0 + 16 * mb + fr;
        const size_t grow = rowbase + (SBM ? (size_t)qi : (size_t)qi * r + p);
        const bf16_t* qp = PJ + grow * NC + qcol + 8 * fq;
        u32x4 raw[4];
#pragma unroll
        for (int ks = 0; ks < 4; ++ks) raw[ks] = *(const u32x4*)(qp + 32 * ks);
        if (!SBM) {
            float f[4][8]; float ss = 0.f;
#pragma unroll
            for (int ks = 0; ks < 4; ++ks) { unpack8(raw[ks], f[ks]);
#pragma unroll
                for (int e = 0; e < 8; ++e) ss += f[ks][e] * f[ks][e]; }
            ss += __shfl_xor(ss, 16); ss += __shfl_xor(ss, 32);
            const float rs = rsqrtf(ss * (1.f / 128.f) + RMS_EPS) * SM_SCALE;
#pragma unroll
            for (int ks = 0; ks < 4; ++ks) { const f32x4 g0 = *(const f32x4*)(qg + 32 * ks + 8 * fq), g1 = *(const f32x4*)(qg + 32 * ks + 8 * fq + 4);
                float o[8]; o[0] = f[ks][0] * rs * g0.x; o[1] = f[ks][1] * rs * g0.y; o[2] = f[ks][2] * rs * g0.z; o[3] = f[ks][3] * rs * g0.w;
                o[4] = f[ks][4] * rs * g1.x; o[5] = f[ks][5] * rs * g1.y; o[6] = f[ks][6] * rs * g1.z; o[7] = f[ks][7] * rs * g1.w;
                raw[ks] = pack8(o); }
        }
#pragma unroll
        for (int ks = 0; ks < 4; ++ks) qf[mb][ks] = __builtin_bit_cast(bf16x8, raw[ks]);
    }
    f32x4 o[8][MB];
#pragma unroll
    for (int c = 0; c < 8; ++c)
#pragma unroll
        for (int mb = 0; mb < MB; ++mb) o[c][mb] = (f32x4){0.f, 0.f, 0.f, 0.f};
    float R[MB], mrun[MB], lrun[MB];
#pragma unroll
    for (int mb = 0; mb < MB; ++mb) { R[mb] = 0.f; mrun[mb] = -1e30f; lrun[mb] = 0.f; }
    float kgv[8];
    if (!SBM) { const f32x4 g0 = *(const f32x4*)(kg + 8 * (tid & 15)), g1 = *(const f32x4*)(kg + 8 * (tid & 15) + 4);
        kgv[0] = g0.x; kgv[1] = g0.y; kgv[2] = g0.z; kgv[3] = g0.w; kgv[4] = g1.x; kgv[5] = g1.y; kgv[6] = g1.z; kgv[7] = g1.w; }

    const int kb_first = SBM ? 4 * qt_or_n + 3 : (qt_or_n == 0 ? 2 : 0);
    const int nkb = SBM ? kb_first + 1 : 4 - kb_first;
    for (int it = 0; it < nkb; ++it) {
        const int kb = SBM ? kb_first - it : kb_first + it;
        const int kbase = SBM ? 64 * kb : 128 * (qt_or_n - 1) + 64 * kb;
        __syncthreads();
#pragma unroll
        for (int i = 0; i < 2; ++i) {
            const int id = tid + 512 * i, rr = id >> 4, ch = id & 15;
            const int ki = kbase + rr;
            const size_t grow = rowbase + (SBM ? (size_t)ki : (size_t)ki * r + p);
            u32x4 kv = *(const u32x4*)(PJ + grow * NC + kcol + 8 * ch);
            const u32x4 vv = *(const u32x4*)(PJ + grow * NC + vcol + 8 * ch);
            if (!SBM) {
                float f[8]; unpack8(kv, f); float ss = 0.f;
#pragma unroll
                for (int e = 0; e < 8; ++e) ss += f[e] * f[e];
                ss += __shfl_xor(ss, 1); ss += __shfl_xor(ss, 2); ss += __shfl_xor(ss, 4); ss += __shfl_xor(ss, 8);
                const float rs = rsqrtf(ss * (1.f / 128.f) + RMS_EPS);
#pragma unroll
                for (int e = 0; e < 8; ++e) f[e] = f[e] * rs * kgv[e];
                kv = pack8(f);
            }
            *(LAS u32x4*)(lds + A_KOFF + rr * KVS + ch * 16) = kv;
            *(LAS u32x4*)(lds + A_VOFF + rr * KVS + ch * 16) = vv;
        }
        __syncthreads();
        bool active;
        if (SBM) active = (kbase < q0 + 31);
        else { const int lo = q0 - 128, hi = q0 + 15; active = (kbase + 63 >= lo) && (kbase <= hi); }
        if (active) {
            f32x4 s[4][MB];
#pragma unroll
            for (int n = 0; n < 4; ++n)
#pragma unroll
                for (int mb = 0; mb < MB; ++mb) s[n][mb] = (f32x4){0.f, 0.f, 0.f, 0.f};
#pragma unroll
            for (int n = 0; n < 4; ++n)
#pragma unroll
                for (int ks = 0; ks < 4; ++ks) { const bf16x8 kf = frag_row(lds + A_KOFF, KVS, 16 * n, 32 * ks, lane);
#pragma unroll
                    for (int mb = 0; mb < MB; ++mb) s[n][mb] = mma(kf, qf[mb][ks], s[n][mb]); }
            bf16x8 pf[MB][2];
#pragma unroll
            for (int mb = 0; mb < MB; ++mb) {
                const int qi = q0 + 16 * mb + fr;
                if (SBM) {
#pragma unroll
                    for (int n = 3; n >= 0; --n) {
                        float z[4], sp[4]; bool va[4];
#pragma unroll
                        for (int j = 0; j < 4; ++j) { const int key = kbase + 16 * n + 4 * fq + j; va[j] = key < qi; z[j] = s[n][mb][j] * SM_SCALE; sp[j] = va[j] ? softplus_f(z[j]) : 0.f; }
                        const float e2 = sp[3], e1 = e2 + sp[2], e0 = e1 + sp[1], tot = e0 + sp[0];
                        const float partner = __shfl_xor(tot, 16); const float a2 = tot + partner; const float b2 = __shfl_xor(a2, 32);
                        const float higher = ((fq & 1) == 0 ? partner : 0.f) + ((fq & 2) == 0 ? b2 : 0.f);
                        const float base = R[mb] + higher;
                        const float tl[4] = {base + e0, base + e1, base + e2, base};
#pragma unroll
                        for (int j = 0; j < 4; ++j) s[n][mb][j] = va[j] ? __expf(z[j] - sp[j] - tl[j]) : 0.f;
                        R[mb] += a2 + b2;
                    }
                } else {
                    float bm = -1e30f; bool va[4][4];
#pragma unroll
                    for (int n = 0; n < 4; ++n)
#pragma unroll
                        for (int j = 0; j < 4; ++j) { const int dist = qi - (kbase + 16 * n + 4 * fq + j); va[n][j] = (dist >= 0) && (dist <= 128); bm = fmaxf(bm, va[n][j] ? s[n][mb][j] : -1e30f); }
                    bm = fmaxf(bm, __shfl_xor(bm, 16)); bm = fmaxf(bm, __shfl_xor(bm, 32));
                    const float mnew = fmaxf(mrun[mb], bm), alpha = __expf(mrun[mb] - mnew);
                    float ps = 0.f;
#pragma unroll
                    for (int n = 0; n < 4; ++n)
#pragma unroll
                        for (int j = 0; j < 4; ++j) { const float pv = va[n][j] ? __expf(s[n][mb][j] - mnew) : 0.f; s[n][mb][j] = pv; ps += pv; }
                    lrun[mb] = lrun[mb] * alpha + ps; mrun[mb] = mnew;
#pragma unroll
                    for (int c = 0; c < 8; ++c) o[c][mb] = o[c][mb] * alpha;
                }
                pf[mb][0] = pack_frag(s[0][mb], s[1][mb]); pf[mb][1] = pack_frag(s[2][mb], s[3][mb]);
            }
#pragma unroll
            for (int c = 0; c < 8; ++c)
#pragma unroll
                for (int s2 = 0; s2 < 2; ++s2) { const bf16x8 vf = frag_tr_alt(lds + A_VOFF, KVS, 32 * s2, 16 * c, lane);
#pragma unroll
                    for (int mb = 0; mb < MB; ++mb) o[c][mb] = mma(vf, pf[mb][s2], o[c][mb]); }
        }
    }
#pragma unroll
    for (int mb = 0; mb < MB; ++mb) {
        const int qi = q0 + 16 * mb + fr;
        const size_t grow = rowbase + (SBM ? (size_t)qi : (size_t)qi * r + p);
        if (SBM) {
            const bf16_t* gp = PJ + grow * NC + 12288 + h * 128 + 4 * fq; bf16_t* op = PJ + grow * NC + h * 128 + 4 * fq;
#pragma unroll
            for (int c = 0; c < 8; ++c) { const u32x2 gw = *(const u32x2*)(gp + 16 * c);
                u32x2 ow; ow.x = cvtpk(o[c][mb][0] * silu_f(bflo(gw.x)), o[c][mb][1] * silu_f(bfhi(gw.x))); ow.y = cvtpk(o[c][mb][2] * silu_f(bflo(gw.y)), o[c][mb][3] * silu_f(bfhi(gw.y)));
                *(u32x2*)(op + 16 * c) = ow; }
        } else {
            float l = lrun[mb]; l += __shfl_xor(l, 16); l += __shfl_xor(l, 32);
            const float inv = 1.0f / l;
            bf16_t* op = OG + ((size_t)g * MH + grow) * 2048 + h * 128 + 4 * fq;
#pragma unroll
            for (int c = 0; c < 8; ++c) { u32x2 ow; ow.x = cvtpk(o[c][mb][0] * inv, o[c][mb][1] * inv); ow.y = cvtpk(o[c][mb][2] * inv, o[c][mb][3] * inv); *(u32x2*)(op + 16 * c) = ow; }
            if (fq == 0) LSE[((size_t)g * MH + grow) * 16 + h] = mrun[mb] + __logf(l);
        }
    }
}

__device__ __forceinline__ void attn_phase(LAS unsigned char* lds, bf16_t* PJ, const float* qg, const float* kg, bf16_t* OG, float* LSE) {
    const int wg = blockIdx.x;
    for (int j = 0; j < 2; ++j) {
        for (int pair = wg; pair < 256; pair += gridDim.x) {
            const int bl = pair >> 7, h = (pair >> 3) & 15, qh = pair & 7, qt = j == 0 ? 15 - qh : qh;
            attn_item<true>(lds, PJ, bl, h, qt, 1, 0, 0, qg, kg, OG, LSE);
        }
    }
    for (int id = wg; id < 2 * 16 * 96; id += gridDim.x) {
        const int bh = id / 96, rem = id % 96, bl = bh >> 4, h = bh & 15;
        int g, r, p, n;
        if (rem < 32) { g = 0; r = 1; p = 0; n = rem; }
        else if (rem < 64) { g = 1; r = 4; p = (rem - 32) >> 3; n = (rem - 32) & 7; }
        else { g = 2; r = 16; p = (rem - 64) >> 1; n = (rem - 64) & 1; }
        attn_item<false>(lds, PJ, bl, h, n, r, p, g, qg, kg, OG, LSE);
    }
}
__device__ __forceinline__ void combine_phase(bf16_t* PJ, const bf16_t* OG, const float* LSE) {
    const size_t total = (size_t)MH * 256, stride = (size_t)gridDim.x * 512;
    for (size_t id = (size_t)blockIdx.x * 512 + opaque_tid(); id < total; id += stride) {
        const size_t row = id >> 8; const int cc = (int)(id & 255), h = cc >> 4;
        const float l0 = LSE[(0 * (size_t)MH + row) * 16 + h], l1 = LSE[(1 * (size_t)MH + row) * 16 + h], l2 = LSE[(2 * (size_t)MH + row) * 16 + h];
        const float mx = fmaxf(l0, fmaxf(l1, l2)); float w0 = __expf(l0 - mx), w1 = __expf(l1 - mx), w2 = __expf(l2 - mx);
        const float inv = 1.0f / (w0 + w1 + w2); w0 *= inv; w1 *= inv; w2 *= inv;
        float a[8], b[8], c[8], gt[8], o[8];
        unpack8(*(const u32x4*)(OG + (0 * (size_t)MH + row) * 2048 + 8 * cc), a);
        unpack8(*(const u32x4*)(OG + (1 * (size_t)MH + row) * 2048 + 8 * cc), b);
        unpack8(*(const u32x4*)(OG + (2 * (size_t)MH + row) * 2048 + 8 * cc), c);
        unpack8(*(const u32x4*)(PJ + row * NC + 12288 + 2048 + 8 * cc), gt);
#pragma unroll
        for (int e = 0; e < 8; ++e) o[e] = (w0 * a[e] + w1 * b[e] + w2 * c[e]) * silu_f(gt[e]);
        *(u32x4*)(PJ + row * NC + 2048 + 8 * cc) = pack8(o);
    }
}

constexpr int H_LF = 0, H_CUM = 32768, H_QT = 65536, H_KT = H_QT + 64 * KVS, H_VT = H_KT + 64 * KVS, H_SBT = H_VT + 64 * 80, H_END = H_SBT + 32 * KVS;
constexpr int VTS = 80;
static_assert(H_END <= 131072, "hgrn lds");
__device__ __forceinline__ void hgrn_item(LAS unsigned char* lds, const bf16_t* PJ, bf16_t* O1, const float* lbl, int bl, int h, int vp) {
    const int tid = opaque_tid(), lane = tid & 63, w = __builtin_amdgcn_readfirstlane(tid >> 6), fr = lane & 15, fq = lane >> 4;
    LAS float* LF = (LAS float*)(lds + H_LF); LAS float* CUM = (LAS float*)(lds + H_CUM);
    const int ch = tid & 15, c0 = 8 * ch;
    float lbv[8], oml[8];
#pragma unroll
    for (int e = 0; e < 8; ++e) { const float d = lbl[DI + h * 128 + c0 + e] - lbl[h * 128 + c0 + e]; lbv[e] = 1.0f / (1.0f + __expf(-d)); oml[e] = 1.0f - lbv[e]; }
    f32x4 S[2] = {(f32x4){0.f, 0.f, 0.f, 0.f}, (f32x4){0.f, 0.f, 0.f, 0.f}};
    const size_t rowbase = (size_t)bl * SEQ;
    const int tb = w >> 1, vb = w & 1;
    for (int ck = 0; ck < SEQ / 64; ++ck) {
        const size_t r0 = rowbase + (size_t)ck * 64;
        u32x4 qraw[2]; float kk[2][8];
#pragma unroll
        for (int i = 0; i < 2; ++i) {
            const int t = (tid >> 4) + 32 * i;
            const bf16_t* rp = PJ + (r0 + t) * NC + h * 128 + c0;
            qraw[i] = *(const u32x4*)rp;
            float fp[8]; unpack8(*(const u32x4*)(rp + 4096), fp);
            float lf[8];
#pragma unroll
            for (int e = 0; e < 8; ++e) { const float sg = 1.0f / (1.0f + __expf(-fp[e])); const float f = lbv[e] + oml[e] * sg; lf[e] = __logf(f); kk[i][e] = oml[e] * (1.0f - sg); }
            *(LAS f32x4*)(LF + t * 128 + c0) = (f32x4){lf[0], lf[1], lf[2], lf[3]};
            *(LAS f32x4*)(LF + t * 128 + c0 + 4) = (f32x4){lf[4], lf[5], lf[6], lf[7]};
        }
        u32x4 vraw = (u32x4){0u, 0u, 0u, 0u};
        if (tid < 256) vraw = *(const u32x4*)(PJ + (r0 + (tid >> 2)) * NC + 8192 + h * 128 + vp * 32 + 8 * (tid & 3));
        __syncthreads();
        { const int c = tid & 127, qr = tid >> 7; float run = 0.f;
            for (int t = 0; t < 16 * qr; ++t) run += LF[t * 128 + c];
#pragma unroll 4
            for (int t = 16 * qr; t < 16 * qr + 16; ++t) { run += LF[t * 128 + c]; CUM[t * 128 + c] = run; } }
        __syncthreads();
        { const f32x4 m0 = *(LAS f32x4*)(CUM + 31 * 128 + c0), m1 = *(LAS f32x4*)(CUM + 31 * 128 + c0 + 4);
            const float cm[8] = {m0.x, m0.y, m0.z, m0.w, m1.x, m1.y, m1.z, m1.w};
#pragma unroll
            for (int i = 0; i < 2; ++i) {
                const int t = (tid >> 4) + 32 * i;
                const f32x4 u0 = *(LAS f32x4*)(CUM + t * 128 + c0), u1 = *(LAS f32x4*)(CUM + t * 128 + c0 + 4);
                const float cu[8] = {u0.x, u0.y, u0.z, u0.w, u1.x, u1.y, u1.z, u1.w};
                float q[8], qt[8], kt[8]; unpack8(qraw[i], q);
#pragma unroll
                for (int e = 0; e < 8; ++e) { const float d = cu[e] - cm[e]; qt[e] = q[e] * __expf(d); kt[e] = kk[i][e] * __expf(-d); }
                *(LAS u32x4*)(lds + H_QT + t * KVS + ch * 16) = pack8(qt);
                *(LAS u32x4*)(lds + H_KT + t * KVS + ch * 16) = pack8(kt);
            }
            if (tid < 256) *(LAS u32x4*)(lds + H_VT + (tid >> 2) * VTS + (tid & 3) * 16) = vraw;
            const f32x4 cs = *(LAS f32x4*)(CUM + 31 * 128 + 16 * w + 4 * fq);
#pragma unroll
            for (int v2 = 0; v2 < 2; ++v2) { u32x2 sw; sw.x = cvtpk(S[v2][0] * __expf(cs.x), S[v2][1] * __expf(cs.y)); sw.y = cvtpk(S[v2][2] * __expf(cs.z), S[v2][3] * __expf(cs.w));
                *(LAS u32x2*)(lds + H_SBT + (fr + 16 * v2) * KVS + (16 * w + 4 * fq) * 2) = sw; }
        }
        __syncthreads();
        {
            bf16x8 qtf[4];
#pragma unroll
            for (int ks = 0; ks < 4; ++ks) qtf[ks] = frag_row(lds + H_QT, KVS, 16 * tb, 32 * ks, lane);
            f32x4 out = (f32x4){0.f, 0.f, 0.f, 0.f};
#pragma unroll
            for (int ks = 0; ks < 4; ++ks) out = mma(frag_row(lds + H_SBT, KVS, 16 * vb, 32 * ks, lane), qtf[ks], out);
            f32x4 at[4];
#pragma unroll
            for (int sb = 0; sb < 4; ++sb) {
                at[sb] = (f32x4){0.f, 0.f, 0.f, 0.f};
                if (sb <= tb) {
#pragma unroll
                    for (int ks = 0; ks < 4; ++ks) at[sb] = mma(frag_row(lds + H_KT, KVS, 16 * sb, 32 * ks, lane), qtf[ks], at[sb]);
                    if (sb == tb) {
#pragma unroll
                        for (int j = 0; j < 4; ++j) if (4 * fq + j > fr) at[sb][j] = 0.f;
                    }
                }
            }
#pragma unroll
            for (int s2 = 0; s2 < 2; ++s2) if (2 * s2 <= tb) out = mma(frag_tr_alt(lds + H_VT, VTS, 32 * s2, 16 * vb, lane), pack_frag(at[2 * s2], at[2 * s2 + 1]), out);
            u32x2 ow; ow.x = cvtpk(out[0], out[1]); ow.y = cvtpk(out[2], out[3]);
            *(u32x2*)(O1 + (r0 + 16 * tb + fr) * DI + h * 128 + vp * 32 + 16 * vb + 4 * fq) = ow;
            const f32x4 cl = *(LAS f32x4*)(CUM + 63 * 128 + 16 * w + 4 * fq), cmm = *(LAS f32x4*)(CUM + 31 * 128 + 16 * w + 4 * fq);
            const bf16x8 kf0 = frag_tr(lds + H_KT, KVS, 0, 16 * w, lane), kf1 = frag_tr(lds + H_KT, KVS, 32, 16 * w, lane);
#pragma unroll
            for (int v2 = 0; v2 < 2; ++v2) {
                f32x4 U = (f32x4){0.f, 0.f, 0.f, 0.f};
                U = mma(kf0, frag_tr(lds + H_VT, VTS, 0, 16 * v2, lane), U);
                U = mma(kf1, frag_tr(lds + H_VT, VTS, 32, 16 * v2, lane), U);
#pragma unroll
                for (int j = 0; j < 4; ++j) S[v2][j] = __expf(cl[j]) * S[v2][j] + __expf(cl[j] - cmm[j]) * U[j];
            }
        }
    }
    __syncthreads();
}
__device__ __forceinline__ void hgrn_post(bf16_t* PJ, const bf16_t* O1, const float* og) {
    const size_t total = (size_t)MH * 512, stride = (size_t)gridDim.x * 512;
    const int tid = opaque_tid(); const int ch = tid & 15;
    const f32x4 g0 = *(const f32x4*)(og + 8 * ch), g1 = *(const f32x4*)(og + 8 * ch + 4);
    const float gg[8] = {g0.x, g0.y, g0.z, g0.w, g1.x, g1.y, g1.z, g1.w};
    for (size_t id = (size_t)blockIdx.x * 512 + tid; id < total; id += stride) {
        const size_t row = id >> 9; const int cc = (int)(id & 511);
        float o[8], gt[8]; unpack8(*(const u32x4*)(O1 + row * DI + 8 * cc), o); unpack8(*(const u32x4*)(PJ + row * NC + 12288 + 8 * cc), gt);
        float ss = 0.f;
#pragma unroll
        for (int e = 0; e < 8; ++e) ss += o[e] * o[e];
        ss += __shfl_xor(ss, 1); ss += __shfl_xor(ss, 2); ss += __shfl_xor(ss, 4); ss += __shfl_xor(ss, 8);
        const float rs = rsqrtf(ss * (1.f / 128.f) + RMS_EPS);
#pragma unroll
        for (int e = 0; e < 8; ++e) o[e] = o[e] * rs * gg[e] * silu_f(gt[e]);
        *(u32x4*)(PJ + row * NC + 8 * cc) = pack8(o);
    }
}

struct Args { const float* in[11]; float* out; unsigned char* ws; unsigned long long pad; };

__global__ void __launch_bounds__(512, 2) fwd(Args a) {
    extern __shared__ __attribute__((aligned(16))) unsigned char lds_raw[];
    LAS unsigned char* lds = (LAS unsigned char*)lds_raw;
    cg::grid_group grid = cg::this_grid();
    const float* x = a.in[0]; const float* norm_even = a.in[1]; const float* w_in_even = a.in[2]; const float* qg = a.in[3]; const float* kg = a.in[4];
    const float* w_out_even = a.in[5]; const float* norm_odd = a.in[6]; const float* w_in_odd = a.in[7]; const float* lbl = a.in[8]; const float* og = a.in[9]; const float* w_out_odd = a.in[10];
    bf16_t* WinT = (bf16_t*)(a.ws + WS_WIN); bf16_t* WoT = (bf16_t*)(a.ws + WS_WO); bf16_t* XN = (bf16_t*)(a.ws + WS_XN); bf16_t* PJ = (bf16_t*)(a.ws + WS_PJ);
    bf16_t* OG = (bf16_t*)(a.ws + WS_OG); float* LSE = (float*)(a.ws + WS_LSE);
    float* out = a.out;

    for (int layer = 0; layer < 2; ++layer) {
        prologue(lds, layer == 0 ? x : out, layer == 0 ? norm_even : norm_odd, layer == 0 ? w_in_even : w_in_odd, layer == 0 ? w_out_even : w_out_odd, WinT, WoT, XN);
        grid.sync();
        for (int half = 0; half < 2; ++half) {
            { pg8::Gemm g{XN + (size_t)half * MH * DM, WinT, MH, NC, DM, DM}; pg8::StaticOrder S; S.init(MH, NC, gridDim.x, blockIdx.x);
              pg8::EpiBf16 E{PJ, NC}; pg8::gemm_phase<pg8::EpiBf16>(lds, g, S, E); }
            grid.sync();
            if (layer == 0) {
                attn_phase(lds, PJ, qg, kg, OG, LSE);
                grid.sync();
                combine_phase(PJ, OG, LSE);
            } else {
                for (int it = blockIdx.x; it < 256; it += gridDim.x) hgrn_item(lds, PJ, OG, lbl, it >> 7, (it >> 2) & 31, it & 3);
                grid.sync();
                hgrn_post(PJ, OG, og);
            }
            grid.sync();
            { pg8::Gemm g{PJ, WoT, MH, DM, DI, NC}; pg8::StaticOrder S; S.init(MH, DM, gridDim.x, blockIdx.x);
              const float* res = (layer == 0 ? x : out) + (size_t)half * MH * DM;
              pg8::EpiRes E{res, out + (size_t)half * MH * DM, DM}; pg8::gemm_phase<pg8::EpiRes>(lds, g, S, E); }
            grid.sync();
        }
    }
}

extern "C" void kernel_launch(void* const* d_in, const int* in_sizes, int n_in, void* d_out, int out_size, void* d_ws, size_t ws_size, hipStream_t stream) {
    static int grid = 0;
    if (grid == 0) {
        if (n_in != 11 || out_size != MTOK * DM || ws_size < WS_END) { fprintf(stderr, "kernel_launch: unexpected shapes (n_in %d out %d ws %zu)\n", n_in, out_size, ws_size); grid = -1; return; }
        int dev = 0, cus = 0, per_cu = 0;
        (void)hipGetDevice(&dev);
        (void)hipDeviceGetAttribute(&cus, hipDeviceAttributeMultiprocessorCount, dev);
        (void)hipFuncSetAttribute((const void*)fwd, hipFuncAttributeMaxDynamicSharedMemorySize, LDS_BYTES);
        (void)hipOccupancyMaxActiveBlocksPerMultiprocessor(&per_cu, (const void*)fwd, 512, LDS_BYTES);
        (void)hipGetLastError();
        grid = cus > 0 ? cus : 256;
    }
    if (grid < 0) return;
    Args a{};
    for (int i = 0; i < 11; ++i) a.in[i] = (const float*)d_in[i];
    a.out = (float*)d_out; a.ws = (unsigned char*)d_ws;
    void* args[] = {&a};
    hipError_t e = hipLaunchCooperativeKernel((const void*)fwd, dim3(grid), dim3(512), args, LDS_BYTES, stream);
    if (e != hipSuccess) fprintf(stderr, "cooperative launch failed: %s\n", hipGetErrorString(e));
}
```

```cpp
#include <hip/hip_runtime.h>
#include <hip/hip_cooperative_groups.h>
#include <cstdio>
namespace cg = cooperative_groups;

#define LAS __attribute__((address_space(3)))
typedef unsigned short bf16_t;
typedef short bf16x8 __attribute__((ext_vector_type(8)));
typedef short s16x4 __attribute__((ext_vector_type(4)));
typedef float f32x4 __attribute__((ext_vector_type(4)));
typedef float f32x2_t __attribute__((ext_vector_type(2)));
typedef __bf16 bf16x2_t __attribute__((ext_vector_type(2)));
typedef unsigned u32x4 __attribute__((ext_vector_type(4)));
typedef unsigned u32x2 __attribute__((ext_vector_type(2)));

constexpr int SEQ = 4096, DM = 2048, NC = 16384, DI = 4096, MTOK = 16384, MH = 8192;
constexpr float RMS_EPS = 1e-6f;
constexpr size_t MiB = 1u << 20;
constexpr size_t WS_WIN = 1 * MiB, WS_WO = 65 * MiB, WS_XN = 81 * MiB, WS_PJ = 145 * MiB, WS_OG = 401 * MiB, WS_LSE = 497 * MiB, WS_END = 499 * MiB;
constexpr int LDS_BYTES = 147456;

__device__ __forceinline__ unsigned cvtpk(float lo, float hi) { f32x2_t v = {lo, hi}; bf16x2_t b = __builtin_convertvector(v, bf16x2_t); return __builtin_bit_cast(unsigned, b); }
__device__ __forceinline__ float bflo(unsigned w) { return __uint_as_float(w << 16); }
__device__ __forceinline__ float bfhi(unsigned w) { return __uint_as_float(w & 0xffff0000u); }
__device__ __forceinline__ void unpack8(const u32x4 w, float* f) { f[0] = bflo(w.x); f[1] = bfhi(w.x); f[2] = bflo(w.y); f[3] = bfhi(w.y); f[4] = bflo(w.z); f[5] = bfhi(w.z); f[6] = bflo(w.w); f[7] = bfhi(w.w); }
__device__ __forceinline__ u32x4 pack8(const float* f) { u32x4 w; w.x = cvtpk(f[0], f[1]); w.y = cvtpk(f[2], f[3]); w.z = cvtpk(f[4], f[5]); w.w = cvtpk(f[6], f[7]); return w; }
__device__ __forceinline__ float silu_f(float g) { return g / (1.0f + __expf(-g)); }
__device__ __forceinline__ float softplus_f(float z) { return fmaxf(z, 0.f) + __logf(1.0f + __expf(-fabsf(z))); }

__device__ __forceinline__ int opaque_tid() { int t = threadIdx.x; asm volatile("" : "+v"(t)); return t; }

__device__ __forceinline__ bf16x8 frag_row(LAS const unsigned char* tile, int stride, int r0, int k0, int lane) {
    return *(LAS const bf16x8*)(tile + (r0 + (lane & 15)) * stride + (k0 + 8 * (lane >> 4)) * 2);
}
__device__ __forceinline__ s16x4 tr4(LAS const unsigned char* p) { return __builtin_bit_cast(s16x4, __builtin_amdgcn_ds_read_tr16_b64_v4i16((LAS s16x4*)p)); }
__device__ __forceinline__ bf16x8 frag_tr(LAS const unsigned char* tile, int stride, int k0, int n0, int lane) {
    const int g = lane >> 4, q = (lane & 15) >> 2, p = lane & 3;
    LAS const unsigned char* a = tile + (k0 + 8 * g + q) * stride + (n0 + 4 * p) * 2;
    const s16x4 lo = tr4(a), hi = tr4(a + 4 * stride);
    return (bf16x8){lo[0], lo[1], lo[2], lo[3], hi[0], hi[1], hi[2], hi[3]};
}
__device__ __forceinline__ bf16x8 frag_tr_alt(LAS const unsigned char* tile, int stride, int k0, int n0, int lane) {
    const int g = lane >> 4, q = (lane & 15) >> 2, p = lane & 3;
    LAS const unsigned char* a = tile + (k0 + 4 * g + q) * stride + (n0 + 4 * p) * 2;
    const s16x4 lo = tr4(a), hi = tr4(a + 16 * stride);
    return (bf16x8){lo[0], lo[1], lo[2], lo[3], hi[0], hi[1], hi[2], hi[3]};
}
__device__ __forceinline__ f32x4 mma(bf16x8 a, bf16x8 b, f32x4 c) { return __builtin_amdgcn_mfma_f32_16x16x32_bf16(a, b, c, 0, 0, 0); }
__device__ __forceinline__ bf16x8 pack_frag(const f32x4 lo, const f32x4 hi) {
    u32x4 w; w.x = cvtpk(lo[0], lo[1]); w.y = cvtpk(lo[2], lo[3]); w.z = cvtpk(hi[0], hi[1]); w.w = cvtpk(hi[2], hi[3]);
    return __builtin_bit_cast(bf16x8, w);
}

namespace pg8 {
constexpr int BM = 256, BK = 64, HALF = 128, HTB = HALF * BK * 2, STAGE_BYTES = 8 * HTB, NXCD = 8, WGM = 8;
__device__ __forceinline__ int lds_byte(int r, int c) { const int st = (r >> 4) * 2 + (c >> 5), rr = r & 15, cc = c & 31, ob = rr * 64 + cc * 2; return st * 1024 + (ob ^ (((ob >> 9) & 1) << 5)); }
__device__ __forceinline__ void stage_rc(int b, int& R, int& C) { const int st = b / 1024, sb = b % 1024, swz = sb ^ (((sb >> 9) & 1) << 5); R = (st >> 1) * 16 + swz / 64; C = (st & 1) * 32 + (swz % 64) / 2; }
__device__ __forceinline__ int perm32(int rho) { const int n = rho >> 4, i = rho & 15; return 8 * (i >> 2) + 4 * n + (i & 3); }
struct Unit { int pm, pn; };
struct Gemm { const bf16_t* A; const bf16_t* Bt; int M, N, K, lda; };
struct StaticOrder {
    int nM, nN, nwg, G, c;
    __device__ void init(int M, int N, int G_, int c_) { nM = M / BM; nN = N / BM; nwg = nM * nN; G = G_; c = c_; }
    __device__ bool next(int i, Unit& u) const {
        const long L = (long)i * G + c; if (L >= nwg) return false;
        int wgid = (int)L; { const int q = nwg / NXCD, r = nwg % NXCD, xcd = wgid % NXCD, off = wgid / NXCD; wgid = (xcd < r ? xcd * (q + 1) : r * (q + 1) + (xcd - r) * q) + off; }
        const int nig = WGM * nN, gid = wgid / nig, fm = gid * WGM, gsz = (nM - fm) < WGM ? (nM - fm) : WGM;
        u.pm = fm + ((wgid % nig) % gsz); u.pn = (wgid % nig) / gsz; return true;
    }
};
struct EpiBf16 {
    static constexpr bool PERM = true;
    bf16_t* O; int ldc;
    __device__ __forceinline__ void operator()(const f32x4 (&acc)[2][2][4][2], const Unit& u, int wr, int wc, int fr, int fq) const {
        const int row0 = u.pm * BM + wr * 64 + fr, col0 = u.pn * BM + wc * 32 + 8 * fq;
#pragma unroll
        for (int ai = 0; ai < 2; ++ai)
#pragma unroll
            for (int m = 0; m < 4; ++m) { bf16_t* rowp = O + (size_t)(row0 + ai * HALF + m * 16) * ldc + col0;
#pragma unroll
                for (int bj = 0; bj < 2; ++bj) { const f32x4 v0 = acc[ai][bj][m][0], v1 = acc[ai][bj][m][1];
                    u32x4 w; w.x = cvtpk(v0[0], v0[1]); w.y = cvtpk(v0[2], v0[3]); w.z = cvtpk(v1[0], v1[1]); w.w = cvtpk(v1[2], v1[3]);
                    *(u32x4*)(rowp + bj * HALF) = w; } }
    }
};
struct EpiRes {
    static constexpr bool PERM = false;
    const float* R; float* C; int ldc;
    __device__ __forceinline__ void operator()(const f32x4 (&acc)[2][2][4][2], const Unit& u, int wr, int wc, int fr, int fq) const {
        const int row0 = u.pm * BM + wr * 64 + fr, col0 = u.pn * BM + wc * 32 + 4 * fq;
#pragma unroll
        for (int ai = 0; ai < 2; ++ai)
#pragma unroll
            for (int m = 0; m < 4; ++m) { const size_t ro = (size_t)(row0 + ai * HALF + m * 16) * ldc + col0;
#pragma unroll
                for (int bj = 0; bj < 2; ++bj)
#pragma unroll
                    for (int n = 0; n < 2; ++n) { const f32x4 r = *(const f32x4*)(R + ro + bj * HALF + n * 16); *(f32x4*)(C + ro + bj * HALF + n * 16) = acc[ai][bj][m][n] + r; } }
    }
};

template <class Epi>
__device__ __forceinline__ void gemm_phase(LAS unsigned char* lds, const Gemm g, const StaticOrder& S, const Epi& E) {
    const int tid = opaque_tid(), wid = __builtin_amdgcn_readfirstlane(tid >> 6), lane = tid & 63, wr = wid >> 2, wc = wid & 3, fr = lane & 15, fq = lane >> 4;
    const int K = g.K, nt = K / BK, lda = g.lda;
    unsigned voffA[2], voffB[2];
#pragma unroll
    for (int i = 0; i < 2; ++i) { int R, C; stage_rc(tid * 16 + i * 8192, R, C); const int Rb = Epi::PERM ? ((R & ~31) + perm32(R & 31)) : R;
        voffA[i] = (unsigned)(R * lda + C) * 2u; voffB[i] = (unsigned)(Rb * K + C) * 2u; }
    const size_t kstep = (size_t)(BK * 2);
    const size_t hstepA = (size_t)HALF * lda * 2, hstepB = (size_t)HALF * K * 2;
    const size_t tstepA = 2 * hstepA, tstepB = 2 * hstepB;
    const unsigned ldsw = (unsigned)wid * 1024u;
    const int aoff = lds_byte(wr * 64 + fr, fq * 8), boff = lds_byte(wc * 32 + fr, fq * 8);
#define PG8_SA(b, h) (((b) * 2 + (h)) * HTB)
#define PG8_SB(b, h) ((4 + (b) * 2 + (h)) * HTB)
#define PG8_STAGE(bufoff, gbase, voff) do { _Pragma("unroll") for (int _i = 0; _i < 2; ++_i) \
        __builtin_amdgcn_global_load_lds((const unsigned*)((const char*)(gbase) + (voff)[_i]), (LAS unsigned*)(lds + (bufoff) + ldsw + _i * 8192), 16, 0, 0); } while (0)
#define PG8_LDA(dst, b, h) do { _Pragma("unroll") for (int m = 0; m < 4; ++m) _Pragma("unroll") for (int k = 0; k < 2; ++k) dst[m][k] = *(const LAS bf16x8*)(lds + PG8_SA(b, h) + aoff + m * 2048 + k * 1024); } while (0)
#define PG8_LDB(dst, b, h) do { _Pragma("unroll") for (int n = 0; n < 2; ++n) _Pragma("unroll") for (int k = 0; k < 2; ++k) dst[n][k] = *(const LAS bf16x8*)(lds + PG8_SB(b, h) + boff + n * 2048 + k * 1024); } while (0)
#define PG8_MMA(ai, bj, At, Bt) do { __builtin_amdgcn_s_setprio(1); _Pragma("unroll") for (int m = 0; m < 4; ++m) _Pragma("unroll") for (int n = 0; n < 2; ++n) _Pragma("unroll") for (int k = 0; k < 2; ++k) \
        acc[ai][bj][m][n] = __builtin_amdgcn_mfma_f32_16x16x32_bf16(Bt[n][k], At[m][k], acc[ai][bj][m][n], 0, 0, 0); __builtin_amdgcn_s_setprio(0); } while (0)
#define PG8_WAIT_V(n) asm volatile("s_waitcnt vmcnt(" #n ")" ::: "memory")
#define PG8_WAIT_L(n) asm volatile("s_waitcnt lgkmcnt(" #n ")" ::: "memory")
#define PG8_BAR __builtin_amdgcn_s_barrier()
#define PG8_SCHED __builtin_amdgcn_sched_barrier(0)
    Unit cur, nxt; int ui = 0;
    if (!S.next(0, cur)) return;
    f32x4 acc[2][2][4][2];
#pragma unroll
    for (int a = 0; a < 2; ++a)
#pragma unroll
        for (int b = 0; b < 2; ++b)
#pragma unroll
            for (int m = 0; m < 4; ++m)
#pragma unroll
                for (int n = 0; n < 2; ++n) acc[a][b][m][n] = (f32x4){0.f, 0.f, 0.f, 0.f};
    bf16x8 At[4][2], B0[2][2], B1[2][2];
    const char* cA = (const char*)g.A + (size_t)cur.pm * tstepA; const char* cB = (const char*)g.Bt + (size_t)cur.pn * tstepB;
    PG8_STAGE(PG8_SB(0, 0), cB, voffB); PG8_STAGE(PG8_SA(0, 0), cA, voffA); PG8_STAGE(PG8_SB(0, 1), cB + hstepB, voffB); PG8_STAGE(PG8_SA(0, 1), cA + hstepA, voffA);
    if (wr == 1) PG8_BAR;
    PG8_WAIT_V(4); PG8_BAR;
    PG8_STAGE(PG8_SB(1, 0), cB + kstep, voffB); PG8_STAGE(PG8_SA(1, 0), cA + kstep, voffA); PG8_STAGE(PG8_SB(1, 1), cB + hstepB + kstep, voffB);
    PG8_WAIT_V(6); PG8_BAR;
    for (;;) {
        const bool has_next = S.next(ui + 1, nxt);
        const char* nA = has_next ? (const char*)g.A + (size_t)nxt.pm * tstepA : cA; const char* nB = has_next ? (const char*)g.Bt + (size_t)nxt.pn * tstepB : cB;
        for (int t = 0; t < nt; t += 2) {
            const bool last = (t == nt - 2);
            const char* a1 = cA + (size_t)(t + 1) * kstep;
            const char* a2 = last ? nA : cA + (size_t)(t + 2) * kstep; const char* b2 = last ? nB : cB + (size_t)(t + 2) * kstep;
            const char* a3 = a2 + kstep; const char* b3 = b2 + kstep;
            PG8_LDB(B0, 0, 0); PG8_SCHED; PG8_LDA(At, 0, 0); PG8_STAGE(PG8_SA(1, 1), a1 + hstepA, voffA);
            PG8_WAIT_L(8); PG8_BAR; PG8_WAIT_L(0); PG8_MMA(0, 0, At, B0); PG8_BAR; PG8_SCHED;
            PG8_LDB(B1, 0, 1); PG8_STAGE(PG8_SB(0, 0), b2, voffB);
            PG8_BAR; PG8_WAIT_L(0); PG8_MMA(0, 1, At, B1); PG8_BAR;
            PG8_LDA(At, 0, 1); PG8_STAGE(PG8_SA(0, 0), a2, voffA);
            PG8_BAR; PG8_WAIT_L(0); PG8_MMA(1, 0, At, B0); PG8_BAR; PG8_SCHED;
            PG8_STAGE(PG8_SB(0, 1), b2 + hstepB, voffB);
            PG8_WAIT_V(6); PG8_BAR; PG8_MMA(1, 1, At, B1); PG8_BAR;
            PG8_LDB(B0, 1, 0); PG8_SCHED; PG8_LDA(At, 1, 0); PG8_STAGE(PG8_SA(0, 1), a2 + hstepA, voffA);
            PG8_WAIT_L(8); PG8_BAR; PG8_WAIT_L(0); PG8_MMA(0, 0, At, B0); PG8_BAR; PG8_SCHED;
            PG8_LDB(B1, 1, 1); PG8_STAGE(PG8_SB(1, 0), b3, voffB);
            PG8_BAR; PG8_WAIT_L(0); PG8_MMA(0, 1, At, B1); PG8_BAR;
            PG8_LDA(At, 1, 1); PG8_STAGE(PG8_SA(1, 0), a3, voffA);
            PG8_BAR; PG8_WAIT_L(0); PG8_MMA(1, 0, At, B0); PG8_BAR; PG8_SCHED;
            PG8_STAGE(PG8_SB(1, 1), b3 + hstepB, voffB);
            PG8_WAIT_V(6); PG8_BAR; PG8_MMA(1, 1, At, B1); PG8_BAR;
        }
        E(acc, cur, wr, wc, fr, fq);
        if (!has_next) break;
#pragma unroll
        for (int a = 0; a < 2; ++a)
#pragma unroll
            for (int b = 0; b < 2; ++b)
#pragma unroll
                for (int m = 0; m < 4; ++m)
#pragma unroll
                    for (int n = 0; n < 2; ++n) acc[a][b][m][n] = (f32x4){0.f, 0.f, 0.f, 0.f};
        cur = nxt; cA = nA; cB = nB; ++ui;
    }
    PG8_WAIT_V(0);
    if (wr == 0) PG8_BAR;
    PG8_BAR;
#undef PG8_SA
#undef PG8_SB
#undef PG8_STAGE
#undef PG8_LDA
#undef PG8_LDB
#undef PG8_MMA
#undef PG8_WAIT_V
#undef PG8_WAIT_L
#undef PG8_BAR
#undef PG8_SCHED
}
}

__device__ __forceinline__ float wave_sum(float v) {
#pragma unroll
    for (int o = 1; o < 64; o <<= 1) v += __shfl_xor(v, o);
    return v;
}
__device__ __forceinline__ void transpose_item(const float* __restrict__ W, int K, int N, bf16_t* __restrict__ WT, LAS float* scr, int item, int lane) {
    const int nblk = N / 32, kb = item / nblk, nb = item % nblk, k0 = 64 * kb, n0 = 32 * nb;
#pragma unroll 8
    for (int i = 0; i < 32; ++i) { const int kk = 2 * i + (lane >> 5); scr[kk * 33 + (lane & 31)] = W[(size_t)(k0 + kk) * N + n0 + (lane & 31)]; }
    asm volatile("s_waitcnt lgkmcnt(0)" ::: "memory");
    const int c = lane & 7;
#pragma unroll
    for (int j = 0; j < 4; ++j) { const int n = (lane >> 3) + 8 * j; const LAS float* s = scr + (8 * c) * 33 + n;
        u32x4 o; o.x = cvtpk(s[0 * 33], s[1 * 33]); o.y = cvtpk(s[2 * 33], s[3 * 33]); o.z = cvtpk(s[4 * 33], s[5 * 33]); o.w = cvtpk(s[6 * 33], s[7 * 33]);
        *(u32x4*)(WT + (size_t)(n0 + n) * K + k0 + 8 * c) = o; }
    asm volatile("s_waitcnt lgkmcnt(0)" ::: "memory");
}
__device__ __forceinline__ void rms_row_to_bf16(const float* xrow, const float* g, bf16_t* orow, int lane) {
    const f32x4* xr = (const f32x4*)xrow + lane; const f32x4* gr = (const f32x4*)g + lane;
    f32x4 v[8]; float s = 0.f;
#pragma unroll
    for (int j = 0; j < 8; ++j) { v[j] = xr[64 * j]; s += (v[j].x * v[j].x + v[j].y * v[j].y) + (v[j].z * v[j].z + v[j].w * v[j].w); }
    const float rstd = rsqrtf(wave_sum(s) * (1.f / DM) + RMS_EPS);
    u32x2* o8 = (u32x2*)orow + lane;
#pragma unroll
    for (int j = 0; j < 8; ++j) { const f32x4 gg = gr[64 * j]; u32x2 w; w.x = cvtpk(v[j].x * rstd * gg.x, v[j].y * rstd * gg.y); w.y = cvtpk(v[j].z * rstd * gg.z, v[j].w * rstd * gg.w); o8[64 * j] = w; }
}
__device__ __forceinline__ void prologue(LAS unsigned char* lds, const float* x, const float* ng, const float* w_in, const float* w_out, bf16_t* WinT, bf16_t* WoT, bf16_t* XN) {
    const int tid = opaque_tid(), lane = tid & 63, wave = tid >> 6;
    LAS float* scr = (LAS float*)(lds + wave * 16384);
    const int gw = blockIdx.x * 8 + wave, NGW = gridDim.x * 8;
    constexpr int I_IN = (DM / 64) * (NC / 32), I_OUT = (DI / 64) * (DM / 32);
    for (int it = gw; it < I_IN + I_OUT; it += NGW) {
        if (it < I_IN) transpose_item(w_in, DM, NC, WinT, scr, it, lane);
        else transpose_item(w_out, DI, DM, WoT, scr, it - I_IN, lane);
    }
    for (int m = gw; m < MTOK; m += NGW) rms_row_to_bf16(x + (size_t)m * DM, ng, XN + (size_t)m * DM, lane);
}

constexpr int KVS = 272;
constexpr int A_KOFF = 0, A_VOFF = 64 * KVS, A_FLAG = 2 * 64 * KVS;
constexpr float SB_STOP = 104.0f;
constexpr float SM_SCALE = 0.08838834764831845f;

template <bool SBM>
__device__ __forceinline__ void attn_item(LAS unsigned char* lds, bf16_t* PJ, int bl, int h, int qt_or_n, int r, int p, int g,
                                          const float* qg, const float* kg, bf16_t* OG, float* LSE) {
    constexpr int MB = SBM ? 2 : 1;
    const int tid = opaque_tid(), lane = tid & 63, w = __builtin_amdgcn_readfirstlane(tid >> 6), fr = lane & 15, fq = lane >> 4;
    const int qcol = SBM ? h * 128 : 6144 + h * 128, kcol = SBM ? 2048 + h * 128 : 8192 + h * 128, vcol = SBM ? 4096 + h * 128 : 10240 + h * 128;
    const size_t rowbase = (size_t)bl * SEQ;
    const int q0 = SBM ? qt_or_n * 256 + 32 * w : qt_or_n * 128 + 16 * w;
    bf16x8 qf[MB][4];
#pragma unroll
    for (int mb = 0; mb < MB; ++mb) {
        const int qi = q0 + 16 * mb + fr;
        const size_t grow = rowbase + (SBM ? (size_t)qi : (size_t)qi * r + p);
        const bf16_t* qp = PJ + grow * NC + qcol + 8 * fq;
        u32x4 raw[4];
#pragma unroll
        for (int ks = 0; ks < 4; ++ks) raw[ks] = *(const u32x4*)(qp + 32 * ks);
        if (!SBM) {
            float f[4][8]; float ss = 0.f;
#pragma unroll
            for (int ks = 0; ks < 4; ++ks) { unpack8(raw[ks], f[ks]);
#pragma unroll
                for (int e = 0; e < 8; ++e) ss += f[ks][e] * f[ks][e]; }
            ss += __shfl_xor(ss, 16); ss += __shfl_xor(ss, 32);
            const float rs = rsqrtf(ss * (1.f / 128.f) + RMS_EPS) * SM_SCALE;
#pragma unroll
            for (int ks = 0; ks < 4; ++ks) { const f32x4 g0 = *(const f32x4*)(qg + 32 * ks + 8 * fq), g1 = *(const f32x4*)(qg + 32 * ks + 8 * fq + 4);
                float o[8]; o[0] = f[ks][0] * rs * g0.x; o[1] = f[ks][1] * rs * g0.y; o[2] = f[ks][2] * rs * g0.z; o[3] = f[ks][3] * rs * g0.w;
                o[4] = f[ks][4] * rs * g1.x; o[5] = f[ks][5] * rs * g1.y; o[6] = f[ks][6] * rs * g1.z; o[7] = f[ks][7] * rs * g1.w;
                raw[ks] = pack8(o); }
        }
#pragma unroll
        for (int ks = 0; ks < 4; ++ks) qf[mb][ks] = __builtin_bit_cast(bf16x8, raw[ks]);
    }
    f32x4 o[8][MB];
#pragma unroll
    for (int c = 0; c < 8; ++c)
#pragma unroll
        for (int mb = 0; mb < MB; ++mb) o[c][mb] = (f32x4){0.f, 0.f, 0.f, 0.f};
    float R[MB], mrun[MB], lrun[MB];
#pragma unroll
    for (int mb = 0; mb < MB; ++mb) { R[mb] = 0.f; mrun[mb] = -1e30f; lrun[mb] = 0.f; }
    float kgv[8];
    if (!SBM) { const f32x4 g0 = *(const f32x4*)(kg + 8 * (tid & 15)), g1 = *(const f32x4*)(kg + 8 * (tid & 15) + 4);
        kgv[0] = g0.x; kgv[1] = g0.y; kgv[2] = g0.z; kgv[3] = g0.w; kgv[4] = g1.x; kgv[5] = g1.y; kgv[6] = g1.z; kgv[7] = g1.w; }

    const int kb_first = SBM ? 4 * qt_or_n + 3 : (qt_or_n == 0 ? 2 : 0);
    const int nkb = SBM ? kb_first + 1 : 4 - kb_first;
    LAS float* flag = (LAS float*)(lds + A_FLAG);
    if (SBM && lane == 0) flag[w] = 0.f;
    u32x4 kreg[2], vreg[2];
#define ATT_LOAD(itx) do { const int kb_ = SBM ? kb_first - (itx) : kb_first + (itx); const int kbase_ = SBM ? 64 * kb_ : 128 * (qt_or_n - 1) + 64 * kb_; \
        _Pragma("unroll") for (int i = 0; i < 2; ++i) { const int id = tid + 512 * i, rr = id >> 4, ch = id & 15; const int ki = kbase_ + rr; \
            const size_t grow = rowbase + (SBM ? (size_t)ki : (size_t)ki * r + p); \
            kreg[i] = *(const u32x4*)(PJ + grow * NC + kcol + 8 * ch); vreg[i] = *(const u32x4*)(PJ + grow * NC + vcol + 8 * ch); } } while (0)
    ATT_LOAD(0);
    for (int it = 0; it < nkb; ++it) {
        const int kb = SBM ? kb_first - it : kb_first + it;
        const int kbase = SBM ? 64 * kb : 128 * (qt_or_n - 1) + 64 * kb;
        __syncthreads();
        if (SBM) {
            const f32x4 f0 = *(LAS f32x4*)flag, f1 = *(LAS f32x4*)(flag + 4);
            const float mn = fminf(fminf(fminf(f0.x, f0.y), fminf(f0.z, f0.w)), fminf(fminf(f1.x, f1.y), fminf(f1.z, f1.w)));
            if (mn >= SB_STOP) break;
        }
#pragma unroll
        for (int i = 0; i < 2; ++i) {
            const int id = tid + 512 * i, rr = id >> 4, ch = id & 15;
            u32x4 kv = kreg[i];
            if (!SBM) {
                float f[8]; unpack8(kv, f); float ss = 0.f;
#pragma unroll
                for (int e = 0; e < 8; ++e) ss += f[e] * f[e];
                ss += __shfl_xor(ss, 1); ss += __shfl_xor(ss, 2); ss += __shfl_xor(ss, 4); ss += __shfl_xor(ss, 8);
                const float rs = rsqrtf(ss * (1.f / 128.f) + RMS_EPS);
#pragma unroll
                for (int e = 0; e < 8; ++e) f[e] = f[e] * rs * kgv[e];
                kv = pack8(f);
            }
            *(LAS u32x4*)(lds + A_KOFF + rr * KVS + ch * 16) = kv;
            *(LAS u32x4*)(lds + A_VOFF + rr * KVS + ch * 16) = vreg[i];
        }
        if (it + 1 < nkb) ATT_LOAD(it + 1);
        __syncthreads();
        bool active;
        if (SBM) active = (kbase < q0 + 31);
        else { const int lo = q0 - 128, hi = q0 + 15; active = (kbase + 63 >= lo) && (kbase <= hi); }
        if (active) {
            f32x4 s[4][MB];
#pragma unroll
            for (int n = 0; n < 4; ++n)
#pragma unroll
                for (int mb = 0; mb < MB; ++mb) s[n][mb] = (f32x4){0.f, 0.f, 0.f, 0.f};
#pragma unroll
            for (int n = 0; n < 4; ++n)
#pragma unroll
                for (int ks = 0; ks < 4; ++ks) { const bf16x8 kf = frag_row(lds + A_KOFF, KVS, 16 * n, 32 * ks, lane);
#pragma unroll
                    for (int mb = 0; mb < MB; ++mb) s[n][mb] = mma(kf, qf[mb][ks], s[n][mb]); }
            bf16x8 pf[MB][2];
#pragma unroll
            for (int mb = 0; mb < MB; ++mb) {
                const int qi = q0 + 16 * mb + fr;
                if (SBM) {
#pragma unroll
                    for (int n = 3; n >= 0; --n) {
                        float z[4], sp[4]; bool va[4];
#pragma unroll
                        for (int j = 0; j < 4; ++j) { const int key = kbase + 16 * n + 4 * fq + j; va[j] = key < qi; z[j] = s[n][mb][j] * SM_SCALE; sp[j] = va[j] ? softplus_f(z[j]) : 0.f; }
                        const float e2 = sp[3], e1 = e2 + sp[2], e0 = e1 + sp[1], tot = e0 + sp[0];
                        const float partner = __shfl_xor(tot, 16); const float a2 = tot + partner; const float b2 = __shfl_xor(a2, 32);
                        const float higher = ((fq & 1) == 0 ? partner : 0.f) + ((fq & 2) == 0 ? b2 : 0.f);
                        const float base = R[mb] + higher;
                        const float tl[4] = {base + e0, base + e1, base + e2, base};
#pragma unroll
                        for (int j = 0; j < 4; ++j) s[n][mb][j] = va[j] ? __expf(z[j] - sp[j] - tl[j]) : 0.f;
                        R[mb] += a2 + b2;
                    }
                } else {
                    float bm = -1e30f; bool va[4][4];
#pragma unroll
                    for (int n = 0; n < 4; ++n)
#pragma unroll
                        for (int j = 0; j < 4; ++j) { const int dist = qi - (kbase + 16 * n + 4 * fq + j); va[n][j] = (dist >= 0) && (dist <= 128); bm = fmaxf(bm, va[n][j] ? s[n][mb][j] : -1e30f); }
                    bm = fmaxf(bm, __shfl_xor(bm, 16)); bm = fmaxf(bm, __shfl_xor(bm, 32));
                    const float mnew = fmaxf(mrun[mb], bm), alpha = __expf(mrun[mb] - mnew);
                    float ps = 0.f;
#pragma unroll
                    for (int n = 0; n < 4; ++n)
#pragma unroll
                        for (int j = 0; j < 4; ++j) { const float pv = va[n][j] ? __expf(s[n][mb][j] - mnew) : 0.f; s[n][mb][j] = pv; ps += pv; }
                    lrun[mb] = lrun[mb] * alpha + ps; mrun[mb] = mnew;
#pragma unroll
                    for (int c = 0; c < 8; ++c) o[c][mb] = o[c][mb] * alpha;
                }
                pf[mb][0] = pack_frag(s[0][mb], s[1][mb]); pf[mb][1] = pack_frag(s[2][mb], s[3][mb]);
            }
#pragma unroll
            for (int c = 0; c < 8; ++c)
#pragma unroll
                for (int s2 = 0; s2 < 2; ++s2) { const bf16x8 vf = frag_tr_alt(lds + A_VOFF, KVS, 32 * s2, 16 * c, lane);
#pragma unroll
                    for (int mb = 0; mb < MB; ++mb) o[c][mb] = mma(vf, pf[mb][s2], o[c][mb]); }
            if (SBM) { float rm = fminf(R[0], R[MB - 1]);
                rm = fminf(rm, __shfl_xor(rm, 1)); rm = fminf(rm, __shfl_xor(rm, 2)); rm = fminf(rm, __shfl_xor(rm, 4)); rm = fminf(rm, __shfl_xor(rm, 8));
                if (lane == 0) flag[w] = rm; }
        }
    }
#undef ATT_LOAD
    __syncthreads();
#pragma unroll
    for (int mb = 0; mb < MB; ++mb) {
        const int qi = q0 + 16 * mb + fr;
        const size_t grow = rowbase + (SBM ? (size_t)qi : (size_t)qi * r + p);
        if (SBM) {
            const bf16_t* gp = PJ + grow * NC + 12288 + h * 128 + 4 * fq; bf16_t* op = PJ + grow * NC + h * 128 + 4 * fq;
#pragma unroll
            for (int c = 0; c < 8; ++c) { const u32x2 gw = *(const u32x2*)(gp + 16 * c);
                u32x2 ow; ow.x = cvtpk(o[c][mb][0] * silu_f(bflo(gw.x)), o[c][mb][1] * silu_f(bfhi(gw.x))); ow.y = cvtpk(o[c][mb][2] * silu_f(bflo(gw.y)), o[c][mb][3] * silu_f(bfhi(gw.y)));
                *(u32x2*)(op + 16 * c) = ow; }
        } else {
            float l = lrun[mb]; l += __shfl_xor(l, 16); l += __shfl_xor(l, 32);
            const float inv = 1.0f / l;
            bf16_t* op = OG + ((size_t)g * MH + grow) * 2048 + h * 128 + 4 * fq;
#pragma unroll
            for (int c = 0; c < 8; ++c) { u32x2 ow; ow.x = cvtpk(o[c][mb][0] * inv, o[c][mb][1] * inv); ow.y = cvtpk(o[c][mb][2] * inv, o[c][mb][3] * inv); *(u32x2*)(op + 16 * c) = ow; }
            if (fq == 0) LSE[((size_t)g * MH + grow) * 16 + h] = mrun[mb] + __logf(l);
        }
    }
}

__device__ __forceinline__ void attn_phase(LAS unsigned char* lds, bf16_t* PJ, const float* qg, const float* kg, bf16_t* OG, float* LSE) {
    const int wg = blockIdx.x;
    for (int j = 0; j < 2; ++j) {
        for (int pair = wg; pair < 256; pair += gridDim.x) {
            const int bl = pair >> 7, h = (pair >> 3) & 15, qh = pair & 7, qt = j == 0 ? 15 - qh : qh;
            attn_item<true>(lds, PJ, bl, h, qt, 1, 0, 0, qg, kg, OG, LSE);
        }
    }
    for (int id = wg; id < 2 * 16 * 96; id += gridDim.x) {
        const int bh = id / 96, rem = id % 96, bl = bh >> 4, h = bh & 15;
        int g, r, p, n;
        if (rem < 32) { g = 0; r = 1; p = 0; n = rem; }
        else if (rem < 64) { g = 1; r = 4; p = (rem - 32) >> 3; n = (rem - 32) & 7; }
        else { g = 2; r = 16; p = (rem - 64) >> 1; n = (rem - 64) & 1; }
        attn_item<false>(lds, PJ, bl, h, n, r, p, g, qg, kg, OG, LSE);
    }
}
__device__ __forceinline__ void combine_phase(bf16_t* PJ, const bf16_t* OG, const float* LSE) {
    const size_t total = (size_t)MH * 256, stride = (size_t)gridDim.x * 512;
    for (size_t id = (size_t)blockIdx.x * 512 + opaque_tid(); id < total; id += stride) {
        const size_t row = id >> 8; const int cc = (int)(id & 255), h = cc >> 4;
        const float l0 = LSE[(0 * (size_t)MH + row) * 16 + h], l1 = LSE[(1 * (size_t)MH + row) * 16 + h], l2 = LSE[(2 * (size_t)MH + row) * 16 + h];
        const float mx = fmaxf(l0, fmaxf(l1, l2)); float w0 = __expf(l0 - mx), w1 = __expf(l1 - mx), w2 = __expf(l2 - mx);
        const float inv = 1.0f / (w0 + w1 + w2); w0 *= inv; w1 *= inv; w2 *= inv;
        float a[8], b[8], c[8], gt[8], o[8];
        unpack8(*(const u32x4*)(OG + (0 * (size_t)MH + row) * 2048 + 8 * cc), a);
        unpack8(*(const u32x4*)(OG + (1 * (size_t)MH + row) * 2048 + 8 * cc), b);
        unpack8(*(const u32x4*)(OG + (2 * (size_t)MH + row) * 2048 + 8 * cc), c);
        unpack8(*(const u32x4*)(PJ + row * NC + 12288 + 2048 + 8 * cc), gt);
#pragma unroll
        for (int e = 0; e < 8; ++e) o[e] = (w0 * a[e] + w1 * b[e] + w2 * c[e]) * silu_f(gt[e]);
        *(u32x4*)(PJ + row * NC + 2048 + 8 * cc) = pack8(o);
    }
}

constexpr int H_LF = 0, H_CUM = 32768, H_QT = 65536, H_KT = H_QT + 64 * KVS, H_VT = H_KT + 64 * KVS, H_SBT = H_VT + 64 * 80, H_PS = H_SBT + 32 * KVS, H_END = H_PS + 2048;
constexpr int VTS = 80;
static_assert(H_END <= 131072, "hgrn lds");
__device__ __forceinline__ void hgrn_item(LAS unsigned char* lds, const bf16_t* PJ, bf16_t* O1, const float* lbl, int bl, int h, int vp) {
    const int tid = opaque_tid(), lane = tid & 63, w = __builtin_amdgcn_readfirstlane(tid >> 6), fr = lane & 15, fq = lane >> 4;
    LAS float* LF = (LAS float*)(lds + H_LF); LAS float* CUM = (LAS float*)(lds + H_CUM);
    const int ch = tid & 15, c0 = 8 * ch;
    float lbv[8], oml[8];
#pragma unroll
    for (int e = 0; e < 8; ++e) { const float d = lbl[DI + h * 128 + c0 + e] - lbl[h * 128 + c0 + e]; lbv[e] = 1.0f / (1.0f + __expf(-d)); oml[e] = 1.0f - lbv[e]; }
    f32x4 S[2] = {(f32x4){0.f, 0.f, 0.f, 0.f}, (f32x4){0.f, 0.f, 0.f, 0.f}};
    const size_t rowbase = (size_t)bl * SEQ;
    const int tb = w >> 1, vb = w & 1;
    LAS float* PS = (LAS float*)(lds + H_PS);
    u32x4 qn[2], fn[2], vn = (u32x4){0u, 0u, 0u, 0u};
#define HG_LOAD(ckx) do { const size_t rr_ = rowbase + (size_t)(ckx) * 64; \
        _Pragma("unroll") for (int i = 0; i < 2; ++i) { const bf16_t* rp = PJ + (rr_ + (tid >> 4) + 32 * i) * NC + h * 128 + c0; qn[i] = *(const u32x4*)rp; fn[i] = *(const u32x4*)(rp + 4096); } \
        if (tid < 256) vn = *(const u32x4*)(PJ + (rr_ + (tid >> 2)) * NC + 8192 + h * 128 + vp * 32 + 8 * (tid & 3)); } while (0)
    HG_LOAD(0);
    for (int ck = 0; ck < SEQ / 64; ++ck) {
        const size_t r0 = rowbase + (size_t)ck * 64;
        u32x4 qraw[2]; float kk[2][8];
        const u32x4 vraw = vn;
#pragma unroll
        for (int i = 0; i < 2; ++i) {
            const int t = (tid >> 4) + 32 * i;
            qraw[i] = qn[i];
            float fp[8]; unpack8(fn[i], fp);
            float lf[8];
#pragma unroll
            for (int e = 0; e < 8; ++e) { const float sg = 1.0f / (1.0f + __expf(-fp[e])); const float f = lbv[e] + oml[e] * sg; lf[e] = __logf(f); kk[i][e] = oml[e] * (1.0f - sg); }
            *(LAS f32x4*)(LF + t * 128 + c0) = (f32x4){lf[0], lf[1], lf[2], lf[3]};
            *(LAS f32x4*)(LF + t * 128 + c0 + 4) = (f32x4){lf[4], lf[5], lf[6], lf[7]};
        }
        if (ck + 1 < SEQ / 64) HG_LOAD(ck + 1);
        __syncthreads();
        { const int c = tid & 127, qr = tid >> 7; float run[16];
#pragma unroll
            for (int i = 0; i < 16; ++i) run[i] = LF[(16 * qr + i) * 128 + c];
#pragma unroll
            for (int i = 1; i < 16; ++i) run[i] += run[i - 1];
            PS[qr * 128 + c] = run[15];
            __syncthreads();
            float off = 0.f;
#pragma unroll
            for (int q2 = 0; q2 < 3; ++q2) { const float pv = PS[q2 * 128 + c]; off += (q2 < qr) ? pv : 0.f; }
#pragma unroll
            for (int i = 0; i < 16; ++i) CUM[(16 * qr + i) * 128 + c] = run[i] + off; }
        __syncthreads();
        { const f32x4 m0 = *(LAS f32x4*)(CUM + 31 * 128 + c0), m1 = *(LAS f32x4*)(CUM + 31 * 128 + c0 + 4);
            const float cm[8] = {m0.x, m0.y, m0.z, m0.w, m1.x, m1.y, m1.z, m1.w};
#pragma unroll
            for (int i = 0; i < 2; ++i) {
                const int t = (tid >> 4) + 32 * i;
                const f32x4 u0 = *(LAS f32x4*)(CUM + t * 128 + c0), u1 = *(LAS f32x4*)(CUM + t * 128 + c0 + 4);
                const float cu[8] = {u0.x, u0.y, u0.z, u0.w, u1.x, u1.y, u1.z, u1.w};
                float q[8], qt[8], kt[8]; unpack8(qraw[i], q);
#pragma unroll
                for (int e = 0; e < 8; ++e) { const float d = cu[e] - cm[e]; qt[e] = q[e] * __expf(d); kt[e] = kk[i][e] * __expf(-d); }
                *(LAS u32x4*)(lds + H_QT + t * KVS + ch * 16) = pack8(qt);
                *(LAS u32x4*)(lds + H_KT + t * KVS + ch * 16) = pack8(kt);
            }
            if (tid < 256) *(LAS u32x4*)(lds + H_VT + (tid >> 2) * VTS + (tid & 3) * 16) = vraw;
            const f32x4 cs = *(LAS f32x4*)(CUM + 31 * 128 + 16 * w + 4 * fq);
#pragma unroll
            for (int v2 = 0; v2 < 2; ++v2) { u32x2 sw; sw.x = cvtpk(S[v2][0] * __expf(cs.x), S[v2][1] * __expf(cs.y)); sw.y = cvtpk(S[v2][2] * __expf(cs.z), S[v2][3] * __expf(cs.w));
                *(LAS u32x2*)(lds + H_SBT + (fr + 16 * v2) * KVS + (16 * w + 4 * fq) * 2) = sw; }
        }
        __syncthreads();
        {
            bf16x8 qtf[4];
#pragma unroll
            for (int ks = 0; ks < 4; ++ks) qtf[ks] = frag_row(lds + H_QT, KVS, 16 * tb, 32 * ks, lane);
            f32x4 out = (f32x4){0.f, 0.f, 0.f, 0.f};
#pragma unroll
            for (int ks = 0; ks < 4; ++ks) out = mma(frag_row(lds + H_SBT, KVS, 16 * vb, 32 * ks, lane), qtf[ks], out);
            f32x4 at[4];
#pragma unroll
            for (int sb = 0; sb < 4; ++sb) {
                at[sb] = (f32x4){0.f, 0.f, 0.f, 0.f};
                if (sb <= tb) {
#pragma unroll
                    for (int ks = 0; ks < 4; ++ks) at[sb] = mma(frag_row(lds + H_KT, KVS, 16 * sb, 32 * ks, lane), qtf[ks], at[sb]);
                    if (sb == tb) {
#pragma unroll
                        for (int j = 0; j < 4; ++j) if (4 * fq + j > fr) at[sb][j] = 0.f;
                    }
                }
            }
#pragma unroll
            for (int s2 = 0; s2 < 2; ++s2) if (2 * s2 <= tb) out = mma(frag_tr_alt(lds + H_VT, VTS, 32 * s2, 16 * vb, lane), pack_frag(at[2 * s2], at[2 * s2 + 1]), out);
            u32x2 ow; ow.x = cvtpk(out[0], out[1]); ow.y = cvtpk(out[2], out[3]);
            *(u32x2*)(O1 + (r0 + 16 * tb + fr) * DI + h * 128 + vp * 32 + 16 * vb + 4 * fq) = ow;
            const f32x4 cl = *(LAS f32x4*)(CUM + 63 * 128 + 16 * w + 4 * fq), cmm = *(LAS f32x4*)(CUM + 31 * 128 + 16 * w + 4 * fq);
            const bf16x8 kf0 = frag_tr(lds + H_KT, KVS, 0, 16 * w, lane), kf1 = frag_tr(lds + H_KT, KVS, 32, 16 * w, lane);
#pragma unroll
            for (int v2 = 0; v2 < 2; ++v2) {
                f32x4 U = (f32x4){0.f, 0.f, 0.f, 0.f};
                U = mma(kf0, frag_tr(lds + H_VT, VTS, 0, 16 * v2, lane), U);
                U = mma(kf1, frag_tr(lds + H_VT, VTS, 32, 16 * v2, lane), U);
#pragma unroll
                for (int j = 0; j < 4; ++j) S[v2][j] = __expf(cl[j]) * S[v2][j] + __expf(cl[j] - cmm[j]) * U[j];
            }
        }
    }
#undef HG_LOAD
    __syncthreads();
}
__device__ __forceinline__ void hgrn_post(bf16_t* PJ, const bf16_t* O1, const float* og) {
    const size_t total = (size_t)MH * 512, stride = (size_t)gridDim.x * 512;
    const int tid = opaque_tid(); const int ch = tid & 15;
    const f32x4 g0 = *(const f32x4*)(og + 8 * ch), g1 = *(const f32x4*)(og + 8 * ch + 4);
    const float gg[8] = {g0.x, g0.y, g0.z, g0.w, g1.x, g1.y, g1.z, g1.w};
    for (size_t id = (size_t)blockIdx.x * 512 + tid; id < total; id += stride) {
        const size_t row = id >> 9; const int cc = (int)(id & 511);
        float o[8], gt[8]; unpack8(*(const u32x4*)(O1 + row * DI + 8 * cc), o); unpack8(*(const u32x4*)(PJ + row * NC + 12288 + 8 * cc), gt);
        float ss = 0.f;
#pragma unroll
        for (int e = 0; e < 8; ++e) ss += o[e] * o[e];
        ss += __shfl_xor(ss, 1); ss += __shfl_xor(ss, 2); ss += __shfl_xor(ss, 4); ss += __shfl_xor(ss, 8);
        const float rs = rsqrtf(ss * (1.f / 128.f) + RMS_EPS);
#pragma unroll
        for (int e = 0; e < 8; ++e) o[e] = o[e] * rs * gg[e] * silu_f(gt[e]);
        *(u32x4*)(PJ + row * NC + 8 * cc) = pack8(o);
    }
}

struct Args { const float* in[11]; float* out; unsigned char* ws; unsigned long long pad; };

__global__ void __launch_bounds__(512, 2) fwd(Args a) {
    extern __shared__ __attribute__((aligned(16))) unsigned char lds_raw[];
    LAS unsigned char* lds = (LAS unsigned char*)lds_raw;
    cg::grid_group grid = cg::this_grid();
    const float* x = a.in[0]; const float* norm_even = a.in[1]; const float* w_in_even = a.in[2]; const float* qg = a.in[3]; const float* kg = a.in[4];
    const float* w_out_even = a.in[5]; const float* norm_odd = a.in[6]; const float* w_in_odd = a.in[7]; const float* lbl = a.in[8]; const float* og = a.in[9]; const float* w_out_odd = a.in[10];
    bf16_t* WinT = (bf16_t*)(a.ws + WS_WIN); bf16_t* WoT = (bf16_t*)(a.ws + WS_WO); bf16_t* XN = (bf16_t*)(a.ws + WS_XN); bf16_t* PJ = (bf16_t*)(a.ws + WS_PJ);
    bf16_t* OG = (bf16_t*)(a.ws + WS_OG); float* LSE = (float*)(a.ws + WS_LSE);
    float* out = a.out;

    for (int layer = 0; layer < 2; ++layer) {
        prologue(lds, layer == 0 ? x : out, layer == 0 ? norm_even : norm_odd, layer == 0 ? w_in_even : w_in_odd, layer == 0 ? w_out_even : w_out_odd, WinT, WoT, XN);
        grid.sync();
        for (int half = 0; half < 2; ++half) {
            { pg8::Gemm g{XN + (size_t)half * MH * DM, WinT, MH, NC, DM, DM}; pg8::StaticOrder S; S.init(MH, NC, gridDim.x, blockIdx.x);
              pg8::EpiBf16 E{PJ, NC}; pg8::gemm_phase<pg8::EpiBf16>(lds, g, S, E); }
            grid.sync();
            if (layer == 0) {
                attn_phase(lds, PJ, qg, kg, OG, LSE);
                grid.sync();
                combine_phase(PJ, OG, LSE);
            } else {
                for (int it = blockIdx.x; it < 256; it += gridDim.x) hgrn_item(lds, PJ, OG, lbl, it >> 7, (it >> 2) & 31, it & 3);
                grid.sync();
                hgrn_post(PJ, OG, og);
            }
            grid.sync();
            { pg8::Gemm g{PJ, WoT, MH, DM, DI, NC}; pg8::StaticOrder S; S.init(MH, DM, gridDim.x, blockIdx.x);
              const float* res = (layer == 0 ? x : out) + (size_t)half * MH * DM;
              pg8::EpiRes E{res, out + (size_t)half * MH * DM, DM}; pg8::gemm_phase<pg8::EpiRes>(lds, g, S, E); }
            grid.sync();
        }
    }
}

extern "C" void kernel_launch(void* const* d_in, const int* in_sizes, int n_in, void* d_out, int out_size, void* d_ws, size_t ws_size, hipStream_t stream) {
    static int grid = 0;
    if (grid == 0) {
        if (n_in != 11 || out_size != MTOK * DM || ws_size < WS_END) { fprintf(stderr, "kernel_launch: unexpected shapes (n_in %d out %d ws %zu)\n", n_in, out_size, ws_size); grid = -1; return; }
        int dev = 0, cus = 0, per_cu = 0;
        (void)hipGetDevice(&dev);
        (void)hipDeviceGetAttribute(&cus, hipDeviceAttributeMultiprocessorCount, dev);
        (void)hipFuncSetAttribute((const void*)fwd, hipFuncAttributeMaxDynamicSharedMemorySize, LDS_BYTES);
        (void)hipOccupancyMaxActiveBlocksPerMultiprocessor(&per_cu, (const void*)fwd, 512, LDS_BYTES);
        (void)hipGetLastError();
        grid = cus > 0 ? cus : 256;
    }
    if (grid < 0) return;
    Args a{};
    for (int i = 0; i < 11; ++i) a.in[i] = (const float*)d_in[i];
    a.out = (float*)d_out; a.ws = (unsigned char*)d_ws;
    void* args[] = {&a};
    hipError_t e = hipLaunchCooperativeKernel((const void*)fwd, dim3(grid), dim3(512), args, LDS_BYTES, stream);
    if (e != hipSuccess) fprintf(stderr, "cooperative launch failed: %s\n", hipGetErrorString(e));
}
```

```cpp
#include <hip/hip_runtime.h>
#include <hip/hip_cooperative_groups.h>
#include <cstdio>
namespace cg = cooperative_groups;

#define LAS __attribute__((address_space(3)))
typedef unsigned short bf16_t;
typedef short bf16x8 __attribute__((ext_vector_type(8)));
typedef short s16x4 __attribute__((ext_vector_type(4)));
typedef float f32x4 __attribute__((ext_vector_type(4)));
typedef float f32x2_t __attribute__((ext_vector_type(2)));
typedef __bf16 bf16x2_t __attribute__((ext_vector_type(2)));
typedef unsigned u32x4 __attribute__((ext_vector_type(4)));
typedef unsigned u32x2 __attribute__((ext_vector_type(2)));

constexpr int SEQ = 4096, DM = 2048, NC = 16384, DI = 4096, MTOK = 16384, MH = 8192;
constexpr float RMS_EPS = 1e-6f;
constexpr size_t MiB = 1u << 20;
constexpr size_t WS_WIN = 1 * MiB, WS_WO = 65 * MiB, WS_XN = 81 * MiB, WS_PJ = 145 * MiB, WS_OG = 401 * MiB, WS_LSE = 497 * MiB, WS_END = 499 * MiB;
constexpr int LDS_BYTES = 147456;

__device__ __forceinline__ unsigned cvtpk(float lo, float hi) { f32x2_t v = {lo, hi}; bf16x2_t b = __builtin_convertvector(v, bf16x2_t); return __builtin_bit_cast(unsigned, b); }
__device__ __forceinline__ float bflo(unsigned w) { return __uint_as_float(w << 16); }
__device__ __forceinline__ float bfhi(unsigned w) { return __uint_as_float(w & 0xffff0000u); }
__device__ __forceinline__ void unpack8(const u32x4 w, float* f) { f[0] = bflo(w.x); f[1] = bfhi(w.x); f[2] = bflo(w.y); f[3] = bfhi(w.y); f[4] = bflo(w.z); f[5] = bfhi(w.z); f[6] = bflo(w.w); f[7] = bfhi(w.w); }
__device__ __forceinline__ u32x4 pack8(const float* f) { u32x4 w; w.x = cvtpk(f[0], f[1]); w.y = cvtpk(f[2], f[3]); w.z = cvtpk(f[4], f[5]); w.w = cvtpk(f[6], f[7]); return w; }
__device__ __forceinline__ float silu_f(float g) { return g / (1.0f + __expf(-g)); }
__device__ __forceinline__ float softplus_f(float z) { return fmaxf(z, 0.f) + __logf(1.0f + __expf(-fabsf(z))); }

__device__ __forceinline__ int opaque_tid() { int t = threadIdx.x; asm volatile("" : "+v"(t)); return t; }

__device__ __forceinline__ size_t pjo(int hg, size_t row) { return ((size_t)hg * MH + row) * 128; }

__device__ __forceinline__ bf16x8 frag_row(LAS const unsigned char* tile, int stride, int r0, int k0, int lane) {
    return *(LAS const bf16x8*)(tile + (r0 + (lane & 15)) * stride + (k0 + 8 * (lane >> 4)) * 2);
}
__device__ __forceinline__ s16x4 tr4(LAS const unsigned char* p) { return __builtin_bit_cast(s16x4, __builtin_amdgcn_ds_read_tr16_b64_v4i16((LAS s16x4*)p)); }
__device__ __forceinline__ bf16x8 frag_tr(LAS const unsigned char* tile, int stride, int k0, int n0, int lane) {
    const int g = lane >> 4, q = (lane & 15) >> 2, p = lane & 3;
    LAS const unsigned char* a = tile + (k0 + 8 * g + q) * stride + (n0 + 4 * p) * 2;
    const s16x4 lo = tr4(a), hi = tr4(a + 4 * stride);
    return (bf16x8){lo[0], lo[1], lo[2], lo[3], hi[0], hi[1], hi[2], hi[3]};
}
__device__ __forceinline__ bf16x8 frag_tr_alt(LAS const unsigned char* tile, int stride, int k0, int n0, int lane) {
    const int g = lane >> 4, q = (lane & 15) >> 2, p = lane & 3;
    LAS const unsigned char* a = tile + (k0 + 4 * g + q) * stride + (n0 + 4 * p) * 2;
    const s16x4 lo = tr4(a), hi = tr4(a + 16 * stride);
    return (bf16x8){lo[0], lo[1], lo[2], lo[3], hi[0], hi[1], hi[2], hi[3]};
}
__device__ __forceinline__ f32x4 mma(bf16x8 a, bf16x8 b, f32x4 c) { return __builtin_amdgcn_mfma_f32_16x16x32_bf16(a, b, c, 0, 0, 0); }
__device__ __forceinline__ bf16x8 pack_frag(const f32x4 lo, const f32x4 hi) {
    u32x4 w; w.x = cvtpk(lo[0], lo[1]); w.y = cvtpk(lo[2], lo[3]); w.z = cvtpk(hi[0], hi[1]); w.w = cvtpk(hi[2], hi[3]);
    return __builtin_bit_cast(bf16x8, w);
}

namespace pg8 {
constexpr int BM = 256, BK = 64, HALF = 128, HTB = HALF * BK * 2, STAGE_BYTES = 8 * HTB, NXCD = 8, WGM = 8;
__device__ __forceinline__ int lds_byte(int r, int c) { const int st = (r >> 4) * 2 + (c >> 5), rr = r & 15, cc = c & 31, ob = rr * 64 + cc * 2; return st * 1024 + (ob ^ (((ob >> 9) & 1) << 5)); }
__device__ __forceinline__ void stage_rc(int b, int& R, int& C) { const int st = b / 1024, sb = b % 1024, swz = sb ^ (((sb >> 9) & 1) << 5); R = (st >> 1) * 16 + swz / 64; C = (st & 1) * 32 + (swz % 64) / 2; }
__device__ __forceinline__ int perm32(int rho) { const int n = rho >> 4, i = rho & 15; return 8 * (i >> 2) + 4 * n + (i & 3); }
struct Unit { int pm, pn; };
struct Gemm { const bf16_t* A; const bf16_t* Bt; int M, N, K, lda, ksh; size_t kbig; };
struct StaticOrder {
    int nM, nN, nwg, G, c;
    __device__ void init(int M, int N, int G_, int c_) { nM = M / BM; nN = N / BM; nwg = nM * nN; G = G_; c = c_; }
    __device__ bool next(int i, Unit& u) const {
        const long L = (long)i * G + c; if (L >= nwg) return false;
        int wgid = (int)L; { const int q = nwg / NXCD, r = nwg % NXCD, xcd = wgid % NXCD, off = wgid / NXCD; wgid = (xcd < r ? xcd * (q + 1) : r * (q + 1) + (xcd - r) * q) + off; }
        const int nig = WGM * nN, gid = wgid / nig, fm = gid * WGM, gsz = (nM - fm) < WGM ? (nM - fm) : WGM;
        u.pm = fm + ((wgid % nig) % gsz); u.pn = (wgid % nig) / gsz; return true;
    }
};
struct EpiBf16 {
    static constexpr bool PERM = true;
    bf16_t* O; int ldc;
    __device__ __forceinline__ void operator()(const f32x4 (&acc)[2][2][4][2], const Unit& u, int wr, int wc, int fr, int fq) const {
        const int row0 = u.pm * BM + wr * 64 + fr, d0 = wc * 32 + 8 * fq;
#pragma unroll
        for (int ai = 0; ai < 2; ++ai)
#pragma unroll
            for (int m = 0; m < 4; ++m) {
#pragma unroll
                for (int bj = 0; bj < 2; ++bj) { const f32x4 v0 = acc[ai][bj][m][0], v1 = acc[ai][bj][m][1];
                    u32x4 w; w.x = cvtpk(v0[0], v0[1]); w.y = cvtpk(v0[2], v0[3]); w.z = cvtpk(v1[0], v1[1]); w.w = cvtpk(v1[2], v1[3]);
                    *(u32x4*)(O + pjo(2 * u.pn + bj, (size_t)(row0 + ai * HALF + m * 16)) + d0) = w; } }
    }
};
struct EpiRes {
    static constexpr bool PERM = false;
    const float* R; float* C; int ldc;
    __device__ __forceinline__ void operator()(const f32x4 (&acc)[2][2][4][2], const Unit& u, int wr, int wc, int fr, int fq) const {
        const int row0 = u.pm * BM + wr * 64 + fr, col0 = u.pn * BM + wc * 32 + 4 * fq;
#pragma unroll
        for (int ai = 0; ai < 2; ++ai)
#pragma unroll
            for (int m = 0; m < 4; ++m) { const size_t ro = (size_t)(row0 + ai * HALF + m * 16) * ldc + col0;
#pragma unroll
                for (int bj = 0; bj < 2; ++bj)
#pragma unroll
                    for (int n = 0; n < 2; ++n) { const f32x4 r = *(const f32x4*)(R + ro + bj * HALF + n * 16); *(f32x4*)(C + ro + bj * HALF + n * 16) = acc[ai][bj][m][n] + r; } }
    }
};

template <class Epi>
__device__ __forceinline__ void gemm_phase(LAS unsigned char* lds, const Gemm g, const StaticOrder& S, const Epi& E) {
    const int tid = opaque_tid(), wid = __builtin_amdgcn_readfirstlane(tid >> 6), lane = tid & 63, wr = wid >> 2, wc = wid & 3, fr = lane & 15, fq = lane >> 4;
    const int K = g.K, nt = K / BK, lda = g.lda, ksh = g.ksh, kmask = (1 << g.ksh) - 1;
    unsigned voffA[2], voffB[2];
#pragma unroll
    for (int i = 0; i < 2; ++i) { int R, C; stage_rc(tid * 16 + i * 8192, R, C); const int Rb = Epi::PERM ? ((R & ~31) + perm32(R & 31)) : R;
        voffA[i] = (unsigned)(R * lda + C) * 2u; voffB[i] = (unsigned)(Rb * K + C) * 2u; }
    const size_t kstep = (size_t)(BK * 2);
    const size_t hstepA = (size_t)HALF * lda * 2, hstepB = (size_t)HALF * K * 2;
    const size_t tstepA = 2 * hstepA, tstepB = 2 * hstepB;
    const unsigned ldsw = (unsigned)wid * 1024u;
    const int aoff = lds_byte(wr * 64 + fr, fq * 8), boff = lds_byte(wc * 32 + fr, fq * 8);
#define PG8_SA(b, h) (((b) * 2 + (h)) * HTB)
#define PG8_SB(b, h) ((4 + (b) * 2 + (h)) * HTB)
#define PG8_STAGE(bufoff, gbase, voff) do { _Pragma("unroll") for (int _i = 0; _i < 2; ++_i) \
        __builtin_amdgcn_global_load_lds((const unsigned*)((const char*)(gbase) + (voff)[_i]), (LAS unsigned*)(lds + (bufoff) + ldsw + _i * 8192), 16, 0, 0); } while (0)
#define PG8_LDA(dst, b, h) do { _Pragma("unroll") for (int m = 0; m < 4; ++m) _Pragma("unroll") for (int k = 0; k < 2; ++k) dst[m][k] = *(const LAS bf16x8*)(lds + PG8_SA(b, h) + aoff + m * 2048 + k * 1024); } while (0)
#define PG8_LDB(dst, b, h) do { _Pragma("unroll") for (int n = 0; n < 2; ++n) _Pragma("unroll") for (int k = 0; k < 2; ++k) dst[n][k] = *(const LAS bf16x8*)(lds + PG8_SB(b, h) + boff + n * 2048 + k * 1024); } while (0)
#define PG8_MMA(ai, bj, At, Bt) do { __builtin_amdgcn_s_setprio(1); _Pragma("unroll") for (int m = 0; m < 4; ++m) _Pragma("unroll") for (int n = 0; n < 2; ++n) _Pragma("unroll") for (int k = 0; k < 2; ++k) \
        acc[ai][bj][m][n] = __builtin_amdgcn_mfma_f32_16x16x32_bf16(Bt[n][k], At[m][k], acc[ai][bj][m][n], 0, 0, 0); __builtin_amdgcn_s_setprio(0); } while (0)
#define PG8_WAIT_V(n) asm volatile("s_waitcnt vmcnt(" #n ")" ::: "memory")
#define PG8_WAIT_L(n) asm volatile("s_waitcnt lgkmcnt(" #n ")" ::: "memory")
#define PG8_BAR __builtin_amdgcn_s_barrier()
#define PG8_SCHED __builtin_amdgcn_sched_barrier(0)
    Unit cur, nxt; int ui = 0;
    if (!S.next(0, cur)) return;
    f32x4 acc[2][2][4][2];
#pragma unroll
    for (int a = 0; a < 2; ++a)
#pragma unroll
        for (int b = 0; b < 2; ++b)
#pragma unroll
            for (int m = 0; m < 4; ++m)
#pragma unroll
                for (int n = 0; n < 2; ++n) acc[a][b][m][n] = (f32x4){0.f, 0.f, 0.f, 0.f};
    bf16x8 At[4][2], B0[2][2], B1[2][2];
    const char* cA = (const char*)g.A + (size_t)cur.pm * tstepA; const char* cB = (const char*)g.Bt + (size_t)cur.pn * tstepB;
    PG8_STAGE(PG8_SB(0, 0), cB, voffB); PG8_STAGE(PG8_SA(0, 0), cA, voffA); PG8_STAGE(PG8_SB(0, 1), cB + hstepB, voffB); PG8_STAGE(PG8_SA(0, 1), cA + hstepA, voffA);
    if (wr == 1) PG8_BAR;
    PG8_WAIT_V(4); PG8_BAR;
    PG8_STAGE(PG8_SB(1, 0), cB + kstep, voffB); PG8_STAGE(PG8_SA(1, 0), cA + kstep, voffA); PG8_STAGE(PG8_SB(1, 1), cB + hstepB + kstep, voffB);
    PG8_WAIT_V(6); PG8_BAR;
    for (;;) {
        const bool has_next = S.next(ui + 1, nxt);
        const char* nA = has_next ? (const char*)g.A + (size_t)nxt.pm * tstepA : cA; const char* nB = has_next ? (const char*)g.Bt + (size_t)nxt.pn * tstepB : cB;
        for (int t = 0; t < nt; t += 2) {
            const bool last = (t == nt - 2);
            const char* a1 = cA + ((size_t)(t >> ksh) * g.kbig + (size_t)(t & kmask) * kstep) + kstep;
            const char* a2 = last ? nA : cA + ((size_t)((t + 2) >> ksh) * g.kbig + (size_t)((t + 2) & kmask) * kstep); const char* b2 = last ? nB : cB + (size_t)(t + 2) * kstep;
            const char* a3 = a2 + kstep; const char* b3 = b2 + kstep;
            PG8_LDB(B0, 0, 0); PG8_SCHED; PG8_LDA(At, 0, 0); PG8_STAGE(PG8_SA(1, 1), a1 + hstepA, voffA);
            PG8_WAIT_L(8); PG8_BAR; PG8_WAIT_L(0); PG8_MMA(0, 0, At, B0); PG8_BAR; PG8_SCHED;
            PG8_LDB(B1, 0, 1); PG8_STAGE(PG8_SB(0, 0), b2, voffB);
            PG8_BAR; PG8_WAIT_L(0); PG8_MMA(0, 1, At, B1); PG8_BAR;
            PG8_LDA(At, 0, 1); PG8_STAGE(PG8_SA(0, 0), a2, voffA);
            PG8_BAR; PG8_WAIT_L(0); PG8_MMA(1, 0, At, B0); PG8_BAR; PG8_SCHED;
            PG8_STAGE(PG8_SB(0, 1), b2 + hstepB, voffB);
            PG8_WAIT_V(6); PG8_BAR; PG8_MMA(1, 1, At, B1); PG8_BAR;
            PG8_LDB(B0, 1, 0); PG8_SCHED; PG8_LDA(At, 1, 0); PG8_STAGE(PG8_SA(0, 1), a2 + hstepA, voffA);
            PG8_WAIT_L(8); PG8_BAR; PG8_WAIT_L(0); PG8_MMA(0, 0, At, B0); PG8_BAR; PG8_SCHED;
            PG8_LDB(B1, 1, 1); PG8_STAGE(PG8_SB(1, 0), b3, voffB);
            PG8_BAR; PG8_WAIT_L(0); PG8_MMA(0, 1, At, B1); PG8_BAR;
            PG8_LDA(At, 1, 1); PG8_STAGE(PG8_SA(1, 0), a3, voffA);
            PG8_BAR; PG8_WAIT_L(0); PG8_MMA(1, 0, At, B0); PG8_BAR; PG8_SCHED;
            PG8_STAGE(PG8_SB(1, 1), b3 + hstepB, voffB);
            PG8_WAIT_V(6); PG8_BAR; PG8_MMA(1, 1, At, B1); PG8_BAR;
        }
        E(acc, cur, wr, wc, fr, fq);
        if (!has_next) break;
#pragma unroll
        for (int a = 0; a < 2; ++a)
#pragma unroll
            for (int b = 0; b < 2; ++b)
#pragma unroll
                for (int m = 0; m < 4; ++m)
#pragma unroll
                    for (int n = 0; n < 2; ++n) acc[a][b][m][n] = (f32x4){0.f, 0.f, 0.f, 0.f};
        cur = nxt; cA = nA; cB = nB; ++ui;
    }
    PG8_WAIT_V(0);
    if (wr == 0) PG8_BAR;
    PG8_BAR;
#undef PG8_SA
#undef PG8_SB
#undef PG8_STAGE
#undef PG8_LDA
#undef PG8_LDB
#undef PG8_MMA
#undef PG8_WAIT_V
#undef PG8_WAIT_L
#undef PG8_BAR
#undef PG8_SCHED
}
}

__device__ __forceinline__ float wave_sum(float v) {
#pragma unroll
    for (int o = 1; o < 64; o <<= 1) v += __shfl_xor(v, o);
    return v;
}
__device__ __forceinline__ void transpose_item(const float* __restrict__ W, int K, int N, bf16_t* __restrict__ WT, LAS float* scr, int item, int lane) {
    const int nblk = N / 32, kb = item / nblk, nb = item % nblk, k0 = 64 * kb, n0 = 32 * nb;
#pragma unroll 8
    for (int i = 0; i < 32; ++i) { const int kk = 2 * i + (lane >> 5); scr[kk * 33 + (lane & 31)] = W[(size_t)(k0 + kk) * N + n0 + (lane & 31)]; }
    asm volatile("s_waitcnt lgkmcnt(0)" ::: "memory");
    const int c = lane & 7;
#pragma unroll
    for (int j = 0; j < 4; ++j) { const int n = (lane >> 3) + 8 * j; const LAS float* s = scr + (8 * c) * 33 + n;
        u32x4 o; o.x = cvtpk(s[0 * 33], s[1 * 33]); o.y = cvtpk(s[2 * 33], s[3 * 33]); o.z = cvtpk(s[4 * 33], s[5 * 33]); o.w = cvtpk(s[6 * 33], s[7 * 33]);
        *(u32x4*)(WT + (size_t)(n0 + n) * K + k0 + 8 * c) = o; }
    asm volatile("s_waitcnt lgkmcnt(0)" ::: "memory");
}
__device__ __forceinline__ void rms_row_to_bf16(const float* xrow, const float* g, bf16_t* orow, int lane) {
    const f32x4* xr = (const f32x4*)xrow + lane; const f32x4* gr = (const f32x4*)g + lane;
    f32x4 v[8]; float s = 0.f;
#pragma unroll
    for (int j = 0; j < 8; ++j) { v[j] = xr[64 * j]; s += (v[j].x * v[j].x + v[j].y * v[j].y) + (v[j].z * v[j].z + v[j].w * v[j].w); }
    const float rstd = rsqrtf(wave_sum(s) * (1.f / DM) + RMS_EPS);
    u32x2* o8 = (u32x2*)orow + lane;
#pragma unroll
    for (int j = 0; j < 8; ++j) { const f32x4 gg = gr[64 * j]; u32x2 w; w.x = cvtpk(v[j].x * rstd * gg.x, v[j].y * rstd * gg.y); w.y = cvtpk(v[j].z * rstd * gg.z, v[j].w * rstd * gg.w); o8[64 * j] = w; }
}
__device__ __forceinline__ void prologue(LAS unsigned char* lds, const float* x, const float* ng, const float* w_in, const float* w_out, bf16_t* WinT, bf16_t* WoT, bf16_t* XN) {
    const int tid = opaque_tid(), lane = tid & 63, wave = tid >> 6;
    LAS float* scr = (LAS float*)(lds + wave * 16384);
    const int gw = blockIdx.x * 8 + wave, NGW = gridDim.x * 8;
    constexpr int I_IN = (DM / 64) * (NC / 32), I_OUT = (DI / 64) * (DM / 32);
    for (int it = gw; it < I_IN + I_OUT; it += NGW) {
        if (it < I_IN) transpose_item(w_in, DM, NC, WinT, scr, it, lane);
        else transpose_item(w_out, DI, DM, WoT, scr, it - I_IN, lane);
    }
    for (int m = gw; m < MTOK; m += NGW) rms_row_to_bf16(x + (size_t)m * DM, ng, XN + (size_t)m * DM, lane);
}

constexpr int KVS = 272;
constexpr int A_KOFF = 0, A_VOFF = 64 * KVS, A_FLAG = 2 * 64 * KVS;
constexpr float SB_STOP = 104.0f;
constexpr float SM_SCALE = 0.08838834764831845f;

template <bool SBM>
__device__ __forceinline__ void attn_item(LAS unsigned char* lds, bf16_t* PJ, int bl, int h, int qt_or_n, int r, int p, int g,
                                          const float* qg, const float* kg, bf16_t* OG, float* LSE) {
    constexpr int MB = SBM ? 2 : 1;
    const int tid = opaque_tid(), lane = tid & 63, w = __builtin_amdgcn_readfirstlane(tid >> 6), fr = lane & 15, fq = lane >> 4;
    const int hq = SBM ? h : 48 + h, hk = SBM ? 16 + h : 64 + h, hv = SBM ? 32 + h : 80 + h;
    const size_t rowbase = (size_t)bl * SEQ;
    const int q0 = SBM ? qt_or_n * 256 + 32 * w : qt_or_n * 128 + 16 * w;
    bf16x8 qf[MB][4];
#pragma unroll
    for (int mb = 0; mb < MB; ++mb) {
        const int qi = q0 + 16 * mb + fr;
        const size_t grow = rowbase + (SBM ? (size_t)qi : (size_t)qi * r + p);
        const bf16_t* qp = PJ + pjo(hq, grow) + 8 * fq;
        u32x4 raw[4];
#pragma unroll
        for (int ks = 0; ks < 4; ++ks) raw[ks] = *(const u32x4*)(qp + 32 * ks);
        if (!SBM) {
            float f[4][8]; float ss = 0.f;
#pragma unroll
            for (int ks = 0; ks < 4; ++ks) { unpack8(raw[ks], f[ks]);
#pragma unroll
                for (int e = 0; e < 8; ++e) ss += f[ks][e] * f[ks][e]; }
            ss += __shfl_xor(ss, 16); ss += __shfl_xor(ss, 32);
            const float rs = rsqrtf(ss * (1.f / 128.f) + RMS_EPS) * SM_SCALE;
#pragma unroll
            for (int ks = 0; ks < 4; ++ks) { const f32x4 g0 = *(const f32x4*)(qg + 32 * ks + 8 * fq), g1 = *(const f32x4*)(qg + 32 * ks + 8 * fq + 4);
                float o[8]; o[0] = f[ks][0] * rs * g0.x; o[1] = f[ks][1] * rs * g0.y; o[2] = f[ks][2] * rs * g0.z; o[3] = f[ks][3] * rs * g0.w;
                o[4] = f[ks][4] * rs * g1.x; o[5] = f[ks][5] * rs * g1.y; o[6] = f[ks][6] * rs * g1.z; o[7] = f[ks][7] * rs * g1.w;
                raw[ks] = pack8(o); }
        }
#pragma unroll
        for (int ks = 0; ks < 4; ++ks) qf[mb][ks] = __builtin_bit_cast(bf16x8, raw[ks]);
    }
    f32x4 o[8][MB];
#pragma unroll
    for (int c = 0; c < 8; ++c)
#pragma unroll
        for (int mb = 0; mb < MB; ++mb) o[c][mb] = (f32x4){0.f, 0.f, 0.f, 0.f};
    float R[MB], mrun[MB], lrun[MB];
#pragma unroll
    for (int mb = 0; mb < MB; ++mb) { R[mb] = 0.f; mrun[mb] = -1e30f; lrun[mb] = 0.f; }
    float kgv[8];
    if (!SBM) { const f32x4 g0 = *(const f32x4*)(kg + 8 * (tid & 15)), g1 = *(const f32x4*)(kg + 8 * (tid & 15) + 4);
        kgv[0] = g0.x; kgv[1] = g0.y; kgv[2] = g0.z; kgv[3] = g0.w; kgv[4] = g1.x; kgv[5] = g1.y; kgv[6] = g1.z; kgv[7] = g1.w; }

    const int kb_first = SBM ? 4 * qt_or_n + 3 : (qt_or_n == 0 ? 2 : 0);
    const int nkb = SBM ? kb_first + 1 : 4 - kb_first;
    LAS float* flag = (LAS float*)(lds + A_FLAG);
    if (SBM && lane == 0) flag[w] = 0.f;
    u32x4 kreg[2], vreg[2];
#define ATT_LOAD(itx) do { const int kb_ = SBM ? kb_first - (itx) : kb_first + (itx); const int kbase_ = SBM ? 64 * kb_ : 128 * (qt_or_n - 1) + 64 * kb_; \
        _Pragma("unroll") for (int i = 0; i < 2; ++i) { const int id = tid + 512 * i, rr = id >> 4, ch = id & 15; const int ki = kbase_ + rr; \
            const size_t grow = rowbase + (SBM ? (size_t)ki : (size_t)ki * r + p); \
            kreg[i] = *(const u32x4*)(PJ + pjo(hk, grow) + 8 * ch); vreg[i] = *(const u32x4*)(PJ + pjo(hv, grow) + 8 * ch); } } while (0)
    ATT_LOAD(0);
    for (int it = 0; it < nkb; ++it) {
        const int kb = SBM ? kb_first - it : kb_first + it;
        const int kbase = SBM ? 64 * kb : 128 * (qt_or_n - 1) + 64 * kb;
        __syncthreads();
        if (SBM) {
            const f32x4 f0 = *(LAS f32x4*)flag, f1 = *(LAS f32x4*)(flag + 4);
            const float mn = fminf(fminf(fminf(f0.x, f0.y), fminf(f0.z, f0.w)), fminf(fminf(f1.x, f1.y), fminf(f1.z, f1.w)));
            if (mn >= SB_STOP) break;
        }
#pragma unroll
        for (int i = 0; i < 2; ++i) {
            const int id = tid + 512 * i, rr = id >> 4, ch = id & 15;
            u32x4 kv = kreg[i];
            if (!SBM) {
                float f[8]; unpack8(kv, f); float ss = 0.f;
#pragma unroll
                for (int e = 0; e < 8; ++e) ss += f[e] * f[e];
                ss += __shfl_xor(ss, 1); ss += __shfl_xor(ss, 2); ss += __shfl_xor(ss, 4); ss += __shfl_xor(ss, 8);
                const float rs = rsqrtf(ss * (1.f / 128.f) + RMS_EPS);
#pragma unroll
                for (int e = 0; e < 8; ++e) f[e] = f[e] * rs * kgv[e];
                kv = pack8(f);
            }
            *(LAS u32x4*)(lds + A_KOFF + rr * KVS + ch * 16) = kv;
            *(LAS u32x4*)(lds + A_VOFF + rr * KVS + ch * 16) = vreg[i];
        }
        if (it + 1 < nkb) ATT_LOAD(it + 1);
        __syncthreads();
        bool active;
        if (SBM) active = (kbase < q0 + 31);
        else { const int lo = q0 - 128, hi = q0 + 15; active = (kbase + 63 >= lo) && (kbase <= hi); }
        if (active) {
            f32x4 s[4][MB];
#pragma unroll
            for (int n = 0; n < 4; ++n)
#pragma unroll
                for (int mb = 0; mb < MB; ++mb) s[n][mb] = (f32x4){0.f, 0.f, 0.f, 0.f};
#pragma unroll
            for (int n = 0; n < 4; ++n)
#pragma unroll
                for (int ks = 0; ks < 4; ++ks) { const bf16x8 kf = frag_row(lds + A_KOFF, KVS, 16 * n, 32 * ks, lane);
#pragma unroll
                    for (int mb = 0; mb < MB; ++mb) s[n][mb] = mma(kf, qf[mb][ks], s[n][mb]); }
            bf16x8 pf[MB][2];
#pragma unroll
            for (int mb = 0; mb < MB; ++mb) {
                const int qi = q0 + 16 * mb + fr;
                if (SBM) {
#pragma unroll
                    for (int n = 3; n >= 0; --n) {
                        float z[4], sp[4]; bool va[4];
#pragma unroll
                        for (int j = 0; j < 4; ++j) { const int key = kbase + 16 * n + 4 * fq + j; va[j] = key < qi; z[j] = s[n][mb][j] * SM_SCALE; sp[j] = va[j] ? softplus_f(z[j]) : 0.f; }
                        const float e2 = sp[3], e1 = e2 + sp[2], e0 = e1 + sp[1], tot = e0 + sp[0];
                        const float partner = __shfl_xor(tot, 16); const float a2 = tot + partner; const float b2 = __shfl_xor(a2, 32);
                        const float higher = ((fq & 1) == 0 ? partner : 0.f) + ((fq & 2) == 0 ? b2 : 0.f);
                        const float base = R[mb] + higher;
                        const float tl[4] = {base + e0, base + e1, base + e2, base};
#pragma unroll
                        for (int j = 0; j < 4; ++j) s[n][mb][j] = va[j] ? __expf(z[j] - sp[j] - tl[j]) : 0.f;
                        R[mb] += a2 + b2;
                    }
                } else {
                    float bm = -1e30f; bool va[4][4];
#pragma unroll
                    for (int n = 0; n < 4; ++n)
#pragma unroll
                        for (int j = 0; j < 4; ++j) { const int dist = qi - (kbase + 16 * n + 4 * fq + j); va[n][j] = (dist >= 0) && (dist <= 128); bm = fmaxf(bm, va[n][j] ? s[n][mb][j] : -1e30f); }
                    bm = fmaxf(bm, __shfl_xor(bm, 16)); bm = fmaxf(bm, __shfl_xor(bm, 32));
                    const float mnew = fmaxf(mrun[mb], bm), alpha = __expf(mrun[mb] - mnew);
                    float ps = 0.f;
#pragma unroll
                    for (int n = 0; n < 4; ++n)
#pragma unroll
                        for (int j = 0; j < 4; ++j) { const float pv = va[n][j] ? __expf(s[n][mb][j] - mnew) : 0.f; s[n][mb][j] = pv; ps += pv; }
                    lrun[mb] = lrun[mb] * alpha + ps; mrun[mb] = mnew;
#pragma unroll
                    for (int c = 0; c < 8; ++c) o[c][mb] = o[c][mb] * alpha;
                }
                pf[mb][0] = pack_frag(s[0][mb], s[1][mb]); pf[mb][1] = pack_frag(s[2][mb], s[3][mb]);
            }
#pragma unroll
            for (int c = 0; c < 8; ++c)
#pragma unroll
                for (int s2 = 0; s2 < 2; ++s2) { const bf16x8 vf = frag_tr_alt(lds + A_VOFF, KVS, 32 * s2, 16 * c, lane);
#pragma unroll
                    for (int mb = 0; mb < MB; ++mb) o[c][mb] = mma(vf, pf[mb][s2], o[c][mb]); }
            if (SBM) { float rm = fminf(R[0], R[MB - 1]);
                rm = fminf(rm, __shfl_xor(rm, 1)); rm = fminf(rm, __shfl_xor(rm, 2)); rm = fminf(rm, __shfl_xor(rm, 4)); rm = fminf(rm, __shfl_xor(rm, 8));
                if (lane == 0) flag[w] = rm; }
        }
    }
#undef ATT_LOAD
    __syncthreads();
#pragma unroll
    for (int mb = 0; mb < MB; ++mb) {
        const int qi = q0 + 16 * mb + fr;
        const size_t grow = rowbase + (SBM ? (size_t)qi : (size_t)qi * r + p);
        if (SBM) {
            const bf16_t* gp = PJ + pjo(96 + h, grow) + 4 * fq; bf16_t* op = PJ + pjo(h, grow) + 4 * fq;
#pragma unroll
            for (int c = 0; c < 8; ++c) { const u32x2 gw = *(const u32x2*)(gp + 16 * c);
                u32x2 ow; ow.x = cvtpk(o[c][mb][0] * silu_f(bflo(gw.x)), o[c][mb][1] * silu_f(bfhi(gw.x))); ow.y = cvtpk(o[c][mb][2] * silu_f(bflo(gw.y)), o[c][mb][3] * silu_f(bfhi(gw.y)));
                *(u32x2*)(op + 16 * c) = ow; }
        } else {
            float l = lrun[mb]; l += __shfl_xor(l, 16); l += __shfl_xor(l, 32);
            const float inv = 1.0f / l;
            bf16_t* op = OG + ((size_t)(g * 16 + h) * MH + grow) * 128 + 4 * fq;
#pragma unroll
            for (int c = 0; c < 8; ++c) { u32x2 ow; ow.x = cvtpk(o[c][mb][0] * inv, o[c][mb][1] * inv); ow.y = cvtpk(o[c][mb][2] * inv, o[c][mb][3] * inv); *(u32x2*)(op + 16 * c) = ow; }
            if (fq == 0) LSE[(size_t)(g * 16 + h) * MH + grow] = mrun[mb] + __logf(l);
        }
    }
}

__device__ __forceinline__ void attn_phase(LAS unsigned char* lds, bf16_t* PJ, const float* qg, const float* kg, bf16_t* OG, float* LSE) {
    const int wg = blockIdx.x;
    for (int j = 0; j < 2; ++j) {
        for (int pair = wg; pair < 256; pair += gridDim.x) {
            const int bl = pair >> 7, h = (pair >> 3) & 15, qh = pair & 7, qt = j == 0 ? 15 - qh : qh;
            attn_item<true>(lds, PJ, bl, h, qt, 1, 0, 0, qg, kg, OG, LSE);
        }
    }
    for (int id = wg; id < 2 * 16 * 96; id += gridDim.x) {
        const int bh = id / 96, rem = id % 96, bl = bh >> 4, h = bh & 15;
        int g, r, p, n;
        if (rem < 32) { g = 0; r = 1; p = 0; n = rem; }
        else if (rem < 64) { g = 1; r = 4; p = (rem - 32) >> 3; n = (rem - 32) & 7; }
        else { g = 2; r = 16; p = (rem - 64) >> 1; n = (rem - 64) & 1; }
        attn_item<false>(lds, PJ, bl, h, n, r, p, g, qg, kg, OG, LSE);
    }
}
__device__ __forceinline__ void combine_phase(bf16_t* PJ, const bf16_t* OG, const float* LSE) {
    const size_t total = (size_t)16 * MH * 16, stride = (size_t)gridDim.x * 512;
    for (size_t id = (size_t)blockIdx.x * 512 + opaque_tid(); id < total; id += stride) {
        const int ch = (int)(id & 15); const size_t hr = id >> 4; const int h = (int)(hr / MH); const size_t row = hr % MH;
        const float l0 = LSE[hr], l1 = LSE[(size_t)16 * MH + hr], l2 = LSE[(size_t)32 * MH + hr];
        const float mx = fmaxf(l0, fmaxf(l1, l2)); float w0 = __expf(l0 - mx), w1 = __expf(l1 - mx), w2 = __expf(l2 - mx);
        const float inv = 1.0f / (w0 + w1 + w2); w0 *= inv; w1 *= inv; w2 *= inv;
        float a[8], b[8], c[8], gt[8], o[8];
        unpack8(*(const u32x4*)(OG + hr * 128 + 8 * ch), a);
        unpack8(*(const u32x4*)(OG + ((size_t)16 * MH + hr) * 128 + 8 * ch), b);
        unpack8(*(const u32x4*)(OG + ((size_t)32 * MH + hr) * 128 + 8 * ch), c);
        unpack8(*(const u32x4*)(PJ + pjo(112 + h, row) + 8 * ch), gt);
#pragma unroll
        for (int e = 0; e < 8; ++e) o[e] = (w0 * a[e] + w1 * b[e] + w2 * c[e]) * silu_f(gt[e]);
        *(u32x4*)(PJ + pjo(16 + h, row) + 8 * ch) = pack8(o);
    }
}

constexpr int H_LF = 0, H_CUM = 32768, H_QT = 65536, H_KT = H_QT + 64 * KVS, H_VT = H_KT + 64 * KVS, H_SBT = H_VT + 64 * 80, H_PS = H_SBT + 32 * KVS, H_END = H_PS + 2048;
constexpr int VTS = 80;
static_assert(H_END <= 131072, "hgrn lds");
__device__ __forceinline__ void hgrn_item(LAS unsigned char* lds, const bf16_t* PJ, bf16_t* O1, const float* lbl, int bl, int h, int vp) {
    const int tid = opaque_tid(), lane = tid & 63, w = __builtin_amdgcn_readfirstlane(tid >> 6), fr = lane & 15, fq = lane >> 4;
    LAS float* LF = (LAS float*)(lds + H_LF); LAS float* CUM = (LAS float*)(lds + H_CUM);
    const int ch = tid & 15, c0 = 8 * ch;
    float lbv[8], oml[8];
#pragma unroll
    for (int e = 0; e < 8; ++e) { const float d = lbl[DI + h * 128 + c0 + e] - lbl[h * 128 + c0 + e]; lbv[e] = 1.0f / (1.0f + __expf(-d)); oml[e] = 1.0f - lbv[e]; }
    f32x4 S[2] = {(f32x4){0.f, 0.f, 0.f, 0.f}, (f32x4){0.f, 0.f, 0.f, 0.f}};
    const size_t rowbase = (size_t)bl * SEQ;
    const int tb = w >> 1, vb = w & 1;
    LAS float* PS = (LAS float*)(lds + H_PS);
    u32x4 qn[2], fn[2], vn = (u32x4){0u, 0u, 0u, 0u};
#define HG_LOAD(ckx) do { const size_t rr_ = rowbase + (size_t)(ckx) * 64; \
        _Pragma("unroll") for (int i = 0; i < 2; ++i) { const size_t ro_ = rr_ + (tid >> 4) + 32 * i; qn[i] = *(const u32x4*)(PJ + pjo(h, ro_) + c0); fn[i] = *(const u32x4*)(PJ + pjo(32 + h, ro_) + c0); } \
        if (tid < 256) vn = *(const u32x4*)(PJ + pjo(64 + h, rr_ + (tid >> 2)) + vp * 32 + 8 * (tid & 3)); } while (0)
    HG_LOAD(0);
    for (int ck = 0; ck < SEQ / 64; ++ck) {
        const size_t r0 = rowbase + (size_t)ck * 64;
        u32x4 qraw[2]; float kk[2][8];
        const u32x4 vraw = vn;
#pragma unroll
        for (int i = 0; i < 2; ++i) {
            const int t = (tid >> 4) + 32 * i;
            qraw[i] = qn[i];
            float fp[8]; unpack8(fn[i], fp);
            float lf[8];
#pragma unroll
            for (int e = 0; e < 8; ++e) { const float sg = 1.0f / (1.0f + __expf(-fp[e])); const float f = lbv[e] + oml[e] * sg; lf[e] = __logf(f); kk[i][e] = oml[e] * (1.0f - sg); }
            *(LAS f32x4*)(LF + t * 128 + c0) = (f32x4){lf[0], lf[1], lf[2], lf[3]};
            *(LAS f32x4*)(LF + t * 128 + c0 + 4) = (f32x4){lf[4], lf[5], lf[6], lf[7]};
        }
        if (ck + 1 < SEQ / 64) HG_LOAD(ck + 1);
        __syncthreads();
        { const int c = tid & 127, qr = tid >> 7; float run[16];
#pragma unroll
            for (int i = 0; i < 16; ++i) run[i] = LF[(16 * qr + i) * 128 + c];
#pragma unroll
            for (int i = 1; i < 16; ++i) run[i] += run[i - 1];
            PS[qr * 128 + c] = run[15];
            __syncthreads();
            float off = 0.f;
#pragma unroll
            for (int q2 = 0; q2 < 3; ++q2) { const float pv = PS[q2 * 128 + c]; off += (q2 < qr) ? pv : 0.f; }
#pragma unroll
            for (int i = 0; i < 16; ++i) CUM[(16 * qr + i) * 128 + c] = run[i] + off; }
        __syncthreads();
        { const f32x4 m0 = *(LAS f32x4*)(CUM + 31 * 128 + c0), m1 = *(LAS f32x4*)(CUM + 31 * 128 + c0 + 4);
            const float cm[8] = {m0.x, m0.y, m0.z, m0.w, m1.x, m1.y, m1.z, m1.w};
#pragma unroll
            for (int i = 0; i < 2; ++i) {
                const int t = (tid >> 4) + 32 * i;
                const f32x4 u0 = *(LAS f32x4*)(CUM + t * 128 + c0), u1 = *(LAS f32x4*)(CUM + t * 128 + c0 + 4);
                const float cu[8] = {u0.x, u0.y, u0.z, u0.w, u1.x, u1.y, u1.z, u1.w};
                float q[8], qt[8], kt[8]; unpack8(qraw[i], q);
#pragma unroll
                for (int e = 0; e < 8; ++e) { const float d = cu[e] - cm[e]; qt[e] = q[e] * __expf(d); kt[e] = kk[i][e] * __expf(-d); }
                *(LAS u32x4*)(lds + H_QT + t * KVS + ch * 16) = pack8(qt);
                *(LAS u32x4*)(lds + H_KT + t * KVS + ch * 16) = pack8(kt);
            }
            if (tid < 256) *(LAS u32x4*)(lds + H_VT + (tid >> 2) * VTS + (tid & 3) * 16) = vraw;
            const f32x4 cs = *(LAS f32x4*)(CUM + 31 * 128 + 16 * w + 4 * fq);
#pragma unroll
            for (int v2 = 0; v2 < 2; ++v2) { u32x2 sw; sw.x = cvtpk(S[v2][0] * __expf(cs.x), S[v2][1] * __expf(cs.y)); sw.y = cvtpk(S[v2][2] * __expf(cs.z), S[v2][3] * __expf(cs.w));
                *(LAS u32x2*)(lds + H_SBT + (fr + 16 * v2) * KVS + (16 * w + 4 * fq) * 2) = sw; }
        }
        __syncthreads();
        {
            bf16x8 qtf[4];
#pragma unroll
            for (int ks = 0; ks < 4; ++ks) qtf[ks] = frag_row(lds + H_QT, KVS, 16 * tb, 32 * ks, lane);
            f32x4 out = (f32x4){0.f, 0.f, 0.f, 0.f};
#pragma unroll
            for (int ks = 0; ks < 4; ++ks) out = mma(frag_row(lds + H_SBT, KVS, 16 * vb, 32 * ks, lane), qtf[ks], out);
            f32x4 at[4];
#pragma unroll
            for (int sb = 0; sb < 4; ++sb) {
                at[sb] = (f32x4){0.f, 0.f, 0.f, 0.f};
                if (sb <= tb) {
#pragma unroll
                    for (int ks = 0; ks < 4; ++ks) at[sb] = mma(frag_row(lds + H_KT, KVS, 16 * sb, 32 * ks, lane), qtf[ks], at[sb]);
                    if (sb == tb) {
#pragma unroll
                        for (int j = 0; j < 4; ++j) if (4 * fq + j > fr) at[sb][j] = 0.f;
                    }
                }
            }
#pragma unroll
            for (int s2 = 0; s2 < 2; ++s2) if (2 * s2 <= tb) out = mma(frag_tr_alt(lds + H_VT, VTS, 32 * s2, 16 * vb, lane), pack_frag(at[2 * s2], at[2 * s2 + 1]), out);
            u32x2 ow; ow.x = cvtpk(out[0], out[1]); ow.y = cvtpk(out[2], out[3]);
            *(u32x2*)(O1 + ((size_t)h * MH + r0 + 16 * tb + fr) * 128 + vp * 32 + 16 * vb + 4 * fq) = ow;
            const f32x4 cl = *(LAS f32x4*)(CUM + 63 * 128 + 16 * w + 4 * fq), cmm = *(LAS f32x4*)(CUM + 31 * 128 + 16 * w + 4 * fq);
            const bf16x8 kf0 = frag_tr(lds + H_KT, KVS, 0, 16 * w, lane), kf1 = frag_tr(lds + H_KT, KVS, 32, 16 * w, lane);
#pragma unroll
            for (int v2 = 0; v2 < 2; ++v2) {
                f32x4 U = (f32x4){0.f, 0.f, 0.f, 0.f};
                U = mma(kf0, frag_tr(lds + H_VT, VTS, 0, 16 * v2, lane), U);
                U = mma(kf1, frag_tr(lds + H_VT, VTS, 32, 16 * v2, lane), U);
#pragma unroll
                for (int j = 0; j < 4; ++j) S[v2][j] = __expf(cl[j]) * S[v2][j] + __expf(cl[j] - cmm[j]) * U[j];
            }
        }
    }
#undef HG_LOAD
    __syncthreads();
}
__device__ __forceinline__ void hgrn_post(bf16_t* PJ, const bf16_t* O1, const float* og) {
    const size_t total = (size_t)32 * MH * 16, stride = (size_t)gridDim.x * 512;
    const int tid = opaque_tid(); const int ch = tid & 15;
    const f32x4 g0 = *(const f32x4*)(og + 8 * ch), g1 = *(const f32x4*)(og + 8 * ch + 4);
    const float gg[8] = {g0.x, g0.y, g0.z, g0.w, g1.x, g1.y, g1.z, g1.w};
    for (size_t id = (size_t)blockIdx.x * 512 + tid; id < total; id += stride) {
        const size_t hr = id >> 4; const int h = (int)(hr / MH); const size_t row = hr % MH;
        float o[8], gt[8]; unpack8(*(const u32x4*)(O1 + hr * 128 + 8 * ch), o); unpack8(*(const u32x4*)(PJ + pjo(96 + h, row) + 8 * ch), gt);
        float ss = 0.f;
#pragma unroll
        for (int e = 0; e < 8; ++e) ss += o[e] * o[e];
        ss += __shfl_xor(ss, 1); ss += __shfl_xor(ss, 2); ss += __shfl_xor(ss, 4); ss += __shfl_xor(ss, 8);
        const float rs = rsqrtf(ss * (1.f / 128.f) + RMS_EPS);
#pragma unroll
        for (int e = 0; e < 8; ++e) o[e] = o[e] * rs * gg[e] * silu_f(gt[e]);
        *(u32x4*)(PJ + pjo(h, row) + 8 * ch) = pack8(o);
    }
}

struct Args { const float* in[11]; float* out; unsigned char* ws; unsigned long long pad; };

__global__ void __launch_bounds__(512, 2) fwd(Args a) {
    extern __shared__ __attribute__((aligned(16))) unsigned char lds_raw[];
    LAS unsigned char* lds = (LAS unsigned char*)lds_raw;
    cg::grid_group grid = cg::this_grid();
    const float* x = a.in[0]; const float* norm_even = a.in[1]; const float* w_in_even = a.in[2]; const float* qg = a.in[3]; const float* kg = a.in[4];
    const float* w_out_even = a.in[5]; const float* norm_odd = a.in[6]; const float* w_in_odd = a.in[7]; const float* lbl = a.in[8]; const float* og = a.in[9]; const float* w_out_odd = a.in[10];
    bf16_t* WinT = (bf16_t*)(a.ws + WS_WIN); bf16_t* WoT = (bf16_t*)(a.ws + WS_WO); bf16_t* XN = (bf16_t*)(a.ws + WS_XN); bf16_t* PJ = (bf16_t*)(a.ws + WS_PJ);
    bf16_t* OG = (bf16_t*)(a.ws + WS_OG); float* LSE = (float*)(a.ws + WS_LSE);
    float* out = a.out;

#ifdef PROBE_SEL
    unsigned long long tprev = __builtin_amdgcn_s_memrealtime(), tacc = 0ull;
#define STAMP(kind) do { const unsigned long long now_ = __builtin_amdgcn_s_memrealtime(); if ((PROBE_SEL >> ((kind) + 8 * layer)) & 1) tacc += now_ - tprev; tprev = now_; } while (0)
#else
#define STAMP(kind) do { } while (0)
#endif
    for (int layer = 0; layer < 2; ++layer) {
        prologue(lds, layer == 0 ? x : out, layer == 0 ? norm_even : norm_odd, layer == 0 ? w_in_even : w_in_odd, layer == 0 ? w_out_even : w_out_odd, WinT, WoT, XN);
        grid.sync(); STAMP(0);
        for (int half = 0; half < 2; ++half) {
            { pg8::Gemm g{XN + (size_t)half * MH * DM, WinT, MH, NC, DM, DM, 5, 0}; pg8::StaticOrder S; S.init(MH, NC, gridDim.x, blockIdx.x);
              pg8::EpiBf16 E{PJ, NC}; pg8::gemm_phase<pg8::EpiBf16>(lds, g, S, E); }
            grid.sync(); STAMP(1);
            if (layer == 0) {
                attn_phase(lds, PJ, qg, kg, OG, LSE);
                grid.sync(); STAMP(2);
                combine_phase(PJ, OG, LSE);
            } else {
                for (int it = blockIdx.x; it < 256; it += gridDim.x) hgrn_item(lds, PJ, OG, lbl, it >> 7, (it >> 2) & 31, it & 3);
                grid.sync(); STAMP(2);
                hgrn_post(PJ, OG, og);
            }
            grid.sync(); STAMP(3);
            { pg8::Gemm g{PJ, WoT, MH, DM, DI, 128, 1, (size_t)MH * 256}; pg8::StaticOrder S; S.init(MH, DM, gridDim.x, blockIdx.x);
              const float* res = (layer == 0 ? x : out) + (size_t)half * MH * DM;
              pg8::EpiRes E{res, out + (size_t)half * MH * DM, DM}; pg8::gemm_phase<pg8::EpiRes>(lds, g, S, E); }
            grid.sync(); STAMP(4);
        }
    }
#ifdef PROBE_SEL
    if (blockIdx.x == 0) { const int K = (int)(tacc / 100ull); for (int i = threadIdx.x; i < K; i += 512) out[i] += 0.125f; }
#endif
}

extern "C" void kernel_launch(void* const* d_in, const int* in_sizes, int n_in, void* d_out, int out_size, void* d_ws, size_t ws_size, hipStream_t stream) {
    static int grid = 0;
    if (grid == 0) {
        if (n_in != 11 || out_size != MTOK * DM || ws_size < WS_END) { fprintf(stderr, "kernel_launch: unexpected shapes (n_in %d out %d ws %zu)\n", n_in, out_size, ws_size); grid = -1; return; }
        int dev = 0, cus = 0, per_cu = 0;
        (void)hipGetDevice(&dev);
        (void)hipDeviceGetAttribute(&cus, hipDeviceAttributeMultiprocessorCount, dev);
        (void)hipFuncSetAttribute((const void*)fwd, hipFuncAttributeMaxDynamicSharedMemorySize, LDS_BYTES);
        (void)hipOccupancyMaxActiveBlocksPerMultiprocessor(&per_cu, (const void*)fwd, 512, LDS_BYTES);
        (void)hipGetLastError();
        grid = cus > 0 ? cus : 256;
    }
    if (grid < 0) return;
    Args a{};
    for (int i = 0; i < 11; ++i) a.in[i] = (const float*)d_in[i];
    a.out = (float*)d_out; a.ws = (unsigned char*)d_ws;
    void* args[] = {&a};
    hipError_t e = hipLaunchCooperativeKernel((const void*)fwd, dim3(grid), dim3(512), args, LDS_BYTES, stream);
    if (e != hipSuccess) fprintf(stderr, "cooperative launch failed: %s\n", hipGetErrorString(e));
}
```

```cpp
#include <hip/hip_runtime.h>
#include <hip/hip_cooperative_groups.h>
#include <cstdio>
namespace cg = cooperative_groups;

#define LAS __attribute__((address_space(3)))
typedef unsigned short bf16_t;
typedef short bf16x8 __attribute__((ext_vector_type(8)));
typedef short s16x4 __attribute__((ext_vector_type(4)));
typedef float f32x4 __attribute__((ext_vector_type(4)));
typedef float f32x2_t __attribute__((ext_vector_type(2)));
typedef __bf16 bf16x2_t __attribute__((ext_vector_type(2)));
typedef unsigned u32x4 __attribute__((ext_vector_type(4)));
typedef unsigned u32x2 __attribute__((ext_vector_type(2)));

constexpr int SEQ = 4096, DM = 2048, NC = 16384, DI = 4096, MTOK = 16384, MH = 8192;
constexpr float RMS_EPS = 1e-6f;
constexpr size_t MiB = 1u << 20;
constexpr size_t WS_WIN = 1 * MiB, WS_WO = 65 * MiB, WS_XN = 81 * MiB, WS_PJ = 145 * MiB, WS_OG = 401 * MiB, WS_LSE = 497 * MiB, WS_END = 499 * MiB;
constexpr int LDS_BYTES = 147456;

__device__ __forceinline__ unsigned cvtpk(float lo, float hi) { f32x2_t v = {lo, hi}; bf16x2_t b = __builtin_convertvector(v, bf16x2_t); return __builtin_bit_cast(unsigned, b); }
__device__ __forceinline__ float bflo(unsigned w) { return __uint_as_float(w << 16); }
__device__ __forceinline__ float bfhi(unsigned w) { return __uint_as_float(w & 0xffff0000u); }
__device__ __forceinline__ void unpack8(const u32x4 w, float* f) { f[0] = bflo(w.x); f[1] = bfhi(w.x); f[2] = bflo(w.y); f[3] = bfhi(w.y); f[4] = bflo(w.z); f[5] = bfhi(w.z); f[6] = bflo(w.w); f[7] = bfhi(w.w); }
__device__ __forceinline__ u32x4 pack8(const float* f) { u32x4 w; w.x = cvtpk(f[0], f[1]); w.y = cvtpk(f[2], f[3]); w.z = cvtpk(f[4], f[5]); w.w = cvtpk(f[6], f[7]); return w; }
__device__ __forceinline__ float silu_f(float g) { return g / (1.0f + __expf(-g)); }
__device__ __forceinline__ float softplus_f(float z) { return fmaxf(z, 0.f) + __logf(1.0f + __expf(-fabsf(z))); }

__device__ __forceinline__ int opaque_tid() { int t = threadIdx.x; asm volatile("" : "+v"(t)); return t; }

__device__ __forceinline__ size_t pjo(int hg, size_t row) { return ((size_t)hg * MH + row) * 128; }

__device__ __forceinline__ bf16x8 frag_row(LAS const unsigned char* tile, int stride, int r0, int k0, int lane) {
    return *(LAS const bf16x8*)(tile + (r0 + (lane & 15)) * stride + (k0 + 8 * (lane >> 4)) * 2);
}
__device__ __forceinline__ s16x4 tr4(LAS const unsigned char* p) { return __builtin_bit_cast(s16x4, __builtin_amdgcn_ds_read_tr16_b64_v4i16((LAS s16x4*)p)); }
__device__ __forceinline__ bf16x8 frag_tr(LAS const unsigned char* tile, int stride, int k0, int n0, int lane) {
    const int g = lane >> 4, q = (lane & 15) >> 2, p = lane & 3;
    LAS const unsigned char* a = tile + (k0 + 8 * g + q) * stride + (n0 + 4 * p) * 2;
    const s16x4 lo = tr4(a), hi = tr4(a + 4 * stride);
    return (bf16x8){lo[0], lo[1], lo[2], lo[3], hi[0], hi[1], hi[2], hi[3]};
}
__device__ __forceinline__ bf16x8 frag_tr_alt(LAS const unsigned char* tile, int stride, int k0, int n0, int lane) {
    const int g = lane >> 4, q = (lane & 15) >> 2, p = lane & 3;
    LAS const unsigned char* a = tile + (k0 + 4 * g + q) * stride + (n0 + 4 * p) * 2;
    const s16x4 lo = tr4(a), hi = tr4(a + 16 * stride);
    return (bf16x8){lo[0], lo[1], lo[2], lo[3], hi[0], hi[1], hi[2], hi[3]};
}
__device__ __forceinline__ f32x4 mma(bf16x8 a, bf16x8 b, f32x4 c) { return __builtin_amdgcn_mfma_f32_16x16x32_bf16(a, b, c, 0, 0, 0); }
__device__ __forceinline__ bf16x8 pack_frag(const f32x4 lo, const f32x4 hi) {
    u32x4 w; w.x = cvtpk(lo[0], lo[1]); w.y = cvtpk(lo[2], lo[3]); w.z = cvtpk(hi[0], hi[1]); w.w = cvtpk(hi[2], hi[3]);
    return __builtin_bit_cast(bf16x8, w);
}

namespace pg8 {
constexpr int BM = 256, BK = 64, HALF = 128, HTB = HALF * BK * 2, STAGE_BYTES = 8 * HTB, NXCD = 8, WGM = 8;
__device__ __forceinline__ int lds_byte(int r, int c) { const int st = (r >> 4) * 2 + (c >> 5), rr = r & 15, cc = c & 31, ob = rr * 64 + cc * 2; return st * 1024 + (ob ^ (((ob >> 9) & 1) << 5)); }
__device__ __forceinline__ void stage_rc(int b, int& R, int& C) { const int st = b / 1024, sb = b % 1024, swz = sb ^ (((sb >> 9) & 1) << 5); R = (st >> 1) * 16 + swz / 64; C = (st & 1) * 32 + (swz % 64) / 2; }
__device__ __forceinline__ int perm32(int rho) { const int n = rho >> 4, i = rho & 15; return 8 * (i >> 2) + 4 * n + (i & 3); }
struct Unit { int pm, pn; };
struct Gemm { const bf16_t* A; const bf16_t* Bt; int M, N, K, lda, ksh; size_t kbig; };
struct StaticOrder {
    int nM, nN, nwg, G, c;
    __device__ void init(int M, int N, int G_, int c_) { nM = M / BM; nN = N / BM; nwg = nM * nN; G = G_; c = c_; }
    __device__ bool next(int i, Unit& u) const {
        const long L = (long)i * G + c; if (L >= nwg) return false;
        int wgid = (int)L; { const int q = nwg / NXCD, r = nwg % NXCD, xcd = wgid % NXCD, off = wgid / NXCD; wgid = (xcd < r ? xcd * (q + 1) : r * (q + 1) + (xcd - r) * q) + off; }
        const int nig = WGM * nN, gid = wgid / nig, fm = gid * WGM, gsz = (nM - fm) < WGM ? (nM - fm) : WGM;
        u.pm = fm + ((wgid % nig) % gsz); u.pn = (wgid % nig) / gsz; return true;
    }
};
struct EpiBf16 {
    static constexpr bool PERM = true;
    bf16_t* O; int ldc;
    __device__ __forceinline__ void operator()(const f32x4 (&acc)[2][2][4][2], const Unit& u, int wr, int wc, int fr, int fq) const {
        const int row0 = u.pm * BM + wr * 64 + fr, d0 = wc * 32 + 8 * fq;
#pragma unroll
        for (int ai = 0; ai < 2; ++ai)
#pragma unroll
            for (int m = 0; m < 4; ++m) {
#pragma unroll
                for (int bj = 0; bj < 2; ++bj) { const f32x4 v0 = acc[ai][bj][m][0], v1 = acc[ai][bj][m][1];
                    u32x4 w; w.x = cvtpk(v0[0], v0[1]); w.y = cvtpk(v0[2], v0[3]); w.z = cvtpk(v1[0], v1[1]); w.w = cvtpk(v1[2], v1[3]);
                    *(u32x4*)(O + pjo(2 * u.pn + bj, (size_t)(row0 + ai * HALF + m * 16)) + d0) = w; } }
    }
};
struct EpiRes {
    static constexpr bool PERM = false;
    const float* R; float* C; int ldc;
    __device__ __forceinline__ void operator()(const f32x4 (&acc)[2][2][4][2], const Unit& u, int wr, int wc, int fr, int fq) const {
        const int row0 = u.pm * BM + wr * 64 + fr, col0 = u.pn * BM + wc * 32 + 4 * fq;
#pragma unroll
        for (int ai = 0; ai < 2; ++ai)
#pragma unroll
            for (int m = 0; m < 4; ++m) { const size_t ro = (size_t)(row0 + ai * HALF + m * 16) * ldc + col0;
#pragma unroll
                for (int bj = 0; bj < 2; ++bj)
#pragma unroll
                    for (int n = 0; n < 2; ++n) { const f32x4 r = *(const f32x4*)(R + ro + bj * HALF + n * 16); *(f32x4*)(C + ro + bj * HALF + n * 16) = acc[ai][bj][m][n] + r; } }
    }
};

template <class Epi>
__device__ __forceinline__ void gemm_phase(LAS unsigned char* lds, const Gemm g, const StaticOrder& S, const Epi& E) {
    const int tid = opaque_tid(), wid = __builtin_amdgcn_readfirstlane(tid >> 6), lane = tid & 63, wr = wid >> 2, wc = wid & 3, fr = lane & 15, fq = lane >> 4;
    const int K = g.K, nt = K / BK, lda = g.lda, ksh = g.ksh, kmask = (1 << g.ksh) - 1;
    unsigned voffA[2], voffB[2];
#pragma unroll
    for (int i = 0; i < 2; ++i) { int R, C; stage_rc(tid * 16 + i * 8192, R, C); const int Rb = Epi::PERM ? ((R & ~31) + perm32(R & 31)) : R;
        voffA[i] = (unsigned)(R * lda + C) * 2u; voffB[i] = (unsigned)(Rb * K + C) * 2u; }
    const size_t kstep = (size_t)(BK * 2);
    const size_t hstepA = (size_t)HALF * lda * 2, hstepB = (size_t)HALF * K * 2;
    const size_t tstepA = 2 * hstepA, tstepB = 2 * hstepB;
    const unsigned ldsw = (unsigned)wid * 1024u;
    const int aoff = lds_byte(wr * 64 + fr, fq * 8), boff = lds_byte(wc * 32 + fr, fq * 8);
#define PG8_SA(b, h) (((b) * 2 + (h)) * HTB)
#define PG8_SB(b, h) ((4 + (b) * 2 + (h)) * HTB)
#define PG8_STAGE(bufoff, gbase, voff) do { _Pragma("unroll") for (int _i = 0; _i < 2; ++_i) \
        __builtin_amdgcn_global_load_lds((const unsigned*)((const char*)(gbase) + (voff)[_i]), (LAS unsigned*)(lds + (bufoff) + ldsw + _i * 8192), 16, 0, 0); } while (0)
#define PG8_LDA(dst, b, h) do { _Pragma("unroll") for (int m = 0; m < 4; ++m) _Pragma("unroll") for (int k = 0; k < 2; ++k) dst[m][k] = *(const LAS bf16x8*)(lds + PG8_SA(b, h) + aoff + m * 2048 + k * 1024); } while (0)
#define PG8_LDB(dst, b, h) do { _Pragma("unroll") for (int n = 0; n < 2; ++n) _Pragma("unroll") for (int k = 0; k < 2; ++k) dst[n][k] = *(const LAS bf16x8*)(lds + PG8_SB(b, h) + boff + n * 2048 + k * 1024); } while (0)
#define PG8_MMA(ai, bj, At, Bt) do { __builtin_amdgcn_s_setprio(1); _Pragma("unroll") for (int m = 0; m < 4; ++m) _Pragma("unroll") for (int n = 0; n < 2; ++n) _Pragma("unroll") for (int k = 0; k < 2; ++k) \
        acc[ai][bj][m][n] = __builtin_amdgcn_mfma_f32_16x16x32_bf16(Bt[n][k], At[m][k], acc[ai][bj][m][n], 0, 0, 0); __builtin_amdgcn_s_setprio(0); } while (0)
#define PG8_WAIT_V(n) asm volatile("s_waitcnt vmcnt(" #n ")" ::: "memory")
#define PG8_WAIT_L(n) asm volatile("s_waitcnt lgkmcnt(" #n ")" ::: "memory")
#define PG8_BAR __builtin_amdgcn_s_barrier()
#define PG8_SCHED __builtin_amdgcn_sched_barrier(0)
    Unit cur, nxt; int ui = 0;
    if (!S.next(0, cur)) return;
    f32x4 acc[2][2][4][2];
#pragma unroll
    for (int a = 0; a < 2; ++a)
#pragma unroll
        for (int b = 0; b < 2; ++b)
#pragma unroll
            for (int m = 0; m < 4; ++m)
#pragma unroll
                for (int n = 0; n < 2; ++n) acc[a][b][m][n] = (f32x4){0.f, 0.f, 0.f, 0.f};
    bf16x8 At[4][2], B0[2][2], B1[2][2];
    const char* cA = (const char*)g.A + (size_t)cur.pm * tstepA; const char* cB = (const char*)g.Bt + (size_t)cur.pn * tstepB;
    PG8_STAGE(PG8_SB(0, 0), cB, voffB); PG8_STAGE(PG8_SA(0, 0), cA, voffA); PG8_STAGE(PG8_SB(0, 1), cB + hstepB, voffB); PG8_STAGE(PG8_SA(0, 1), cA + hstepA, voffA);
    if (wr == 1) PG8_BAR;
    PG8_WAIT_V(4); PG8_BAR;
    PG8_STAGE(PG8_SB(1, 0), cB + kstep, voffB); PG8_STAGE(PG8_SA(1, 0), cA + kstep, voffA); PG8_STAGE(PG8_SB(1, 1), cB + hstepB + kstep, voffB);
    PG8_WAIT_V(6); PG8_BAR;
    for (;;) {
        const bool has_next = S.next(ui + 1, nxt);
        const char* nA = has_next ? (const char*)g.A + (size_t)nxt.pm * tstepA : cA; const char* nB = has_next ? (const char*)g.Bt + (size_t)nxt.pn * tstepB : cB;
        for (int t = 0; t < nt; t += 2) {
            const bool last = (t == nt - 2);
            const char* a1 = cA + ((size_t)(t >> ksh) * g.kbig + (size_t)(t & kmask) * kstep) + kstep;
            const char* a2 = last ? nA : cA + ((size_t)((t + 2) >> ksh) * g.kbig + (size_t)((t + 2) & kmask) * kstep); const char* b2 = last ? nB : cB + (size_t)(t + 2) * kstep;
            const char* a3 = a2 + kstep; const char* b3 = b2 + kstep;
            PG8_LDB(B0, 0, 0); PG8_SCHED; PG8_LDA(At, 0, 0); PG8_STAGE(PG8_SA(1, 1), a1 + hstepA, voffA);
            PG8_WAIT_L(8); PG8_BAR; PG8_WAIT_L(0); PG8_MMA(0, 0, At, B0); PG8_BAR; PG8_SCHED;
            PG8_LDB(B1, 0, 1); PG8_STAGE(PG8_SB(0, 0), b2, voffB);
            PG8_BAR; PG8_WAIT_L(0); PG8_MMA(0, 1, At, B1); PG8_BAR;
            PG8_LDA(At, 0, 1); PG8_STAGE(PG8_SA(0, 0), a2, voffA);
            PG8_BAR; PG8_WAIT_L(0); PG8_MMA(1, 0, At, B0); PG8_BAR; PG8_SCHED;
            PG8_STAGE(PG8_SB(0, 1), b2 + hstepB, voffB);
            PG8_WAIT_V(6); PG8_BAR; PG8_MMA(1, 1, At, B1); PG8_BAR;
            PG8_LDB(B0, 1, 0); PG8_SCHED; PG8_LDA(At, 1, 0); PG8_STAGE(PG8_SA(0, 1), a2 + hstepA, voffA);
            PG8_WAIT_L(8); PG8_BAR; PG8_WAIT_L(0); PG8_MMA(0, 0, At, B0); PG8_BAR; PG8_SCHED;
            PG8_LDB(B1, 1, 1); PG8_STAGE(PG8_SB(1, 0), b3, voffB);
            PG8_BAR; PG8_WAIT_L(0); PG8_MMA(0, 1, At, B1); PG8_BAR;
            PG8_LDA(At, 1, 1); PG8_STAGE(PG8_SA(1, 0), a3, voffA);
            PG8_BAR; PG8_WAIT_L(0); PG8_MMA(1, 0, At, B0); PG8_BAR; PG8_SCHED;
            PG8_STAGE(PG8_SB(1, 1), b3 + hstepB, voffB);
            PG8_WAIT_V(6); PG8_BAR; PG8_MMA(1, 1, At, B1); PG8_BAR;
        }
        E(acc, cur, wr, wc, fr, fq);
        if (!has_next) break;
#pragma unroll
        for (int a = 0; a < 2; ++a)
#pragma unroll
            for (int b = 0; b < 2; ++b)
#pragma unroll
                for (int m = 0; m < 4; ++m)
#pragma unroll
                    for (int n = 0; n < 2; ++n) acc[a][b][m][n] = (f32x4){0.f, 0.f, 0.f, 0.f};
        cur = nxt; cA = nA; cB = nB; ++ui;
    }
    PG8_WAIT_V(0);
    if (wr == 0) PG8_BAR;
    PG8_BAR;
#undef PG8_SA
#undef PG8_SB
#undef PG8_STAGE
#undef PG8_LDA
#undef PG8_LDB
#undef PG8_MMA
#undef PG8_WAIT_V
#undef PG8_WAIT_L
#undef PG8_BAR
#undef PG8_SCHED
}
}

__device__ __forceinline__ float wave_sum(float v) {
#pragma unroll
    for (int o = 1; o < 64; o <<= 1) v += __shfl_xor(v, o);
    return v;
}
__device__ __forceinline__ void transpose_item(const float* __restrict__ W, int K, int N, bf16_t* __restrict__ WT, LAS float* scr, int item, int lane) {
    const int nblk = N / 32, kb = item / nblk, nb = item % nblk, k0 = 64 * kb, n0 = 32 * nb;
#pragma unroll 8
    for (int i = 0; i < 32; ++i) { const int kk = 2 * i + (lane >> 5); scr[kk * 33 + (lane & 31)] = W[(size_t)(k0 + kk) * N + n0 + (lane & 31)]; }
    asm volatile("s_waitcnt lgkmcnt(0)" ::: "memory");
    const int c = lane & 7;
#pragma unroll
    for (int j = 0; j < 4; ++j) { const int n = (lane >> 3) + 8 * j; const LAS float* s = scr + (8 * c) * 33 + n;
        u32x4 o; o.x = cvtpk(s[0 * 33], s[1 * 33]); o.y = cvtpk(s[2 * 33], s[3 * 33]); o.z = cvtpk(s[4 * 33], s[5 * 33]); o.w = cvtpk(s[6 * 33], s[7 * 33]);
        *(u32x4*)(WT + (size_t)(n0 + n) * K + k0 + 8 * c) = o; }
    asm volatile("s_waitcnt lgkmcnt(0)" ::: "memory");
}
__device__ __forceinline__ void rms_row_to_bf16(const float* xrow, const float* g, bf16_t* orow, int lane) {
    const f32x4* xr = (const f32x4*)xrow + lane; const f32x4* gr = (const f32x4*)g + lane;
    f32x4 v[8]; float s = 0.f;
#pragma unroll
    for (int j = 0; j < 8; ++j) { v[j] = xr[64 * j]; s += (v[j].x * v[j].x + v[j].y * v[j].y) + (v[j].z * v[j].z + v[j].w * v[j].w); }
    const float rstd = rsqrtf(wave_sum(s) * (1.f / DM) + RMS_EPS);
    u32x2* o8 = (u32x2*)orow + lane;
#pragma unroll
    for (int j = 0; j < 8; ++j) { const f32x4 gg = gr[64 * j]; u32x2 w; w.x = cvtpk(v[j].x * rstd * gg.x, v[j].y * rstd * gg.y); w.y = cvtpk(v[j].z * rstd * gg.z, v[j].w * rstd * gg.w); o8[64 * j] = w; }
}
__device__ __forceinline__ void prologue(LAS unsigned char* lds, const float* x, const float* ng, const float* w_in, const float* w_out, bf16_t* WinT, bf16_t* WoT, bf16_t* XN) {
    const int tid = opaque_tid(), lane = tid & 63, wave = tid >> 6;
    LAS float* scr = (LAS float*)(lds + wave * 16384);
    const int gw = blockIdx.x * 8 + wave, NGW = gridDim.x * 8;
    constexpr int I_IN = (DM / 64) * (NC / 32), I_OUT = (DI / 64) * (DM / 32);
    for (int it = gw; it < I_IN + I_OUT; it += NGW) {
        if (it < I_IN) transpose_item(w_in, DM, NC, WinT, scr, it, lane);
        else transpose_item(w_out, DI, DM, WoT, scr, it - I_IN, lane);
    }
    for (int m = gw; m < MTOK; m += NGW) rms_row_to_bf16(x + (size_t)m * DM, ng, XN + (size_t)m * DM, lane);
}

constexpr int KVS = 272;
constexpr int A_KOFF = 0, A_VOFF = 64 * KVS, A_FLAG = 2 * 64 * KVS;
constexpr float SB_STOP = 104.0f;
constexpr float SM_SCALE = 0.08838834764831845f;

template <bool SBM>
__device__ __forceinline__ void attn_item(LAS unsigned char* lds, bf16_t* PJ, int bl, int h, int qt_or_n, int r, int p, int g,
                                          const float* qg, const float* kg, bf16_t* OG, float* LSE) {
    constexpr int MB = SBM ? 2 : 1;
    const int tid = opaque_tid(), lane = tid & 63, w = __builtin_amdgcn_readfirstlane(tid >> 6), fr = lane & 15, fq = lane >> 4;
    const int hq = SBM ? h : 48 + h, hk = SBM ? 16 + h : 64 + h, hv = SBM ? 32 + h : 80 + h;
    const size_t rowbase = (size_t)bl * SEQ;
    const int q0 = SBM ? qt_or_n * 256 + 32 * w : qt_or_n * 128 + 16 * w;
    bf16x8 qf[MB][4];
#pragma unroll
    for (int mb = 0; mb < MB; ++mb) {
        const int qi = q0 + 16 * mb + fr;
        const size_t grow = rowbase + (SBM ? (size_t)qi : (size_t)qi * r + p);
        const bf16_t* qp = PJ + pjo(hq, grow) + 8 * fq;
        u32x4 raw[4];
#pragma unroll
        for (int ks = 0; ks < 4; ++ks) raw[ks] = *(const u32x4*)(qp + 32 * ks);
        if (!SBM) {
            float f[4][8]; float ss = 0.f;
#pragma unroll
            for (int ks = 0; ks < 4; ++ks) { unpack8(raw[ks], f[ks]);
#pragma unroll
                for (int e = 0; e < 8; ++e) ss += f[ks][e] * f[ks][e]; }
            ss += __shfl_xor(ss, 16); ss += __shfl_xor(ss, 32);
            const float rs = rsqrtf(ss * (1.f / 128.f) + RMS_EPS) * SM_SCALE;
#pragma unroll
            for (int ks = 0; ks < 4; ++ks) { const f32x4 g0 = *(const f32x4*)(qg + 32 * ks + 8 * fq), g1 = *(const f32x4*)(qg + 32 * ks + 8 * fq + 4);
                float o[8]; o[0] = f[ks][0] * rs * g0.x; o[1] = f[ks][1] * rs * g0.y; o[2] = f[ks][2] * rs * g0.z; o[3] = f[ks][3] * rs * g0.w;
                o[4] = f[ks][4] * rs * g1.x; o[5] = f[ks][5] * rs * g1.y; o[6] = f[ks][6] * rs * g1.z; o[7] = f[ks][7] * rs * g1.w;
                raw[ks] = pack8(o); }
        }
#pragma unroll
        for (int ks = 0; ks < 4; ++ks) qf[mb][ks] = __builtin_bit_cast(bf16x8, raw[ks]);
    }
    f32x4 o[8][MB];
#pragma unroll
    for (int c = 0; c < 8; ++c)
#pragma unroll
        for (int mb = 0; mb < MB; ++mb) o[c][mb] = (f32x4){0.f, 0.f, 0.f, 0.f};
    float R[MB], mrun[MB], lrun[MB];
#pragma unroll
    for (int mb = 0; mb < MB; ++mb) { R[mb] = 0.f; mrun[mb] = -1e30f; lrun[mb] = 0.f; }
    float kgv[8];
    if (!SBM) { const f32x4 g0 = *(const f32x4*)(kg + 8 * (tid & 15)), g1 = *(const f32x4*)(kg + 8 * (tid & 15) + 4);
        kgv[0] = g0.x; kgv[1] = g0.y; kgv[2] = g0.z; kgv[3] = g0.w; kgv[4] = g1.x; kgv[5] = g1.y; kgv[6] = g1.z; kgv[7] = g1.w; }

    const int kb_first = SBM ? 4 * qt_or_n + 3 : (qt_or_n == 0 ? 2 : 0);
    const int nkb = SBM ? kb_first + 1 : 4 - kb_first;
    LAS float* flag = (LAS float*)(lds + A_FLAG);
    if (SBM && lane == 0) flag[w] = 0.f;
    u32x4 kreg[2], vreg[2];
#define ATT_LOAD(itx) do { const int kb_ = SBM ? kb_first - (itx) : kb_first + (itx); const int kbase_ = SBM ? 64 * kb_ : 128 * (qt_or_n - 1) + 64 * kb_; \
        _Pragma("unroll") for (int i = 0; i < 2; ++i) { const int id = tid + 512 * i, rr = id >> 4, ch = id & 15; const int ki = kbase_ + rr; \
            const size_t grow = rowbase + (SBM ? (size_t)ki : (size_t)ki * r + p); \
            kreg[i] = *(const u32x4*)(PJ + pjo(hk, grow) + 8 * ch); vreg[i] = *(const u32x4*)(PJ + pjo(hv, grow) + 8 * ch); } } while (0)
    ATT_LOAD(0);
    for (int it = 0; it < nkb; ++it) {
        const int kb = SBM ? kb_first - it : kb_first + it;
        const int kbase = SBM ? 64 * kb : 128 * (qt_or_n - 1) + 64 * kb;
        __syncthreads();
        if (SBM) {
            const f32x4 f0 = *(LAS f32x4*)flag, f1 = *(LAS f32x4*)(flag + 4);
            const float mn = fminf(fminf(fminf(f0.x, f0.y), fminf(f0.z, f0.w)), fminf(fminf(f1.x, f1.y), fminf(f1.z, f1.w)));
            if (mn >= SB_STOP) break;
        }
#pragma unroll
        for (int i = 0; i < 2; ++i) {
            const int id = tid + 512 * i, rr = id >> 4, ch = id & 15;
            u32x4 kv = kreg[i];
            if (!SBM) {
                float f[8]; unpack8(kv, f); float ss = 0.f;
#pragma unroll
                for (int e = 0; e < 8; ++e) ss += f[e] * f[e];
                ss += __shfl_xor(ss, 1); ss += __shfl_xor(ss, 2); ss += __shfl_xor(ss, 4); ss += __shfl_xor(ss, 8);
                const float rs = rsqrtf(ss * (1.f / 128.f) + RMS_EPS);
#pragma unroll
                for (int e = 0; e < 8; ++e) f[e] = f[e] * rs * kgv[e];
                kv = pack8(f);
            }
            *(LAS u32x4*)(lds + A_KOFF + rr * KVS + ch * 16) = kv;
            *(LAS u32x4*)(lds + A_VOFF + rr * KVS + ch * 16) = vreg[i];
        }
        if (it + 1 < nkb) ATT_LOAD(it + 1);
        __syncthreads();
        bool active;
        if (SBM) active = (kbase < q0 + 31);
        else { const int lo = q0 - 128, hi = q0 + 15; active = (kbase + 63 >= lo) && (kbase <= hi); }
        if (active) {
            f32x4 s[4][MB];
#pragma unroll
            for (int n = 0; n < 4; ++n)
#pragma unroll
                for (int mb = 0; mb < MB; ++mb) s[n][mb] = (f32x4){0.f, 0.f, 0.f, 0.f};
#pragma unroll
            for (int n = 0; n < 4; ++n)
#pragma unroll
                for (int ks = 0; ks < 4; ++ks) { const bf16x8 kf = frag_row(lds + A_KOFF, KVS, 16 * n, 32 * ks, lane);
#pragma unroll
                    for (int mb = 0; mb < MB; ++mb) s[n][mb] = mma(kf, qf[mb][ks], s[n][mb]); }
            bf16x8 pf[MB][2];
#pragma unroll
            for (int mb = 0; mb < MB; ++mb) {
                const int qi = q0 + 16 * mb + fr;
                if (SBM) {
#pragma unroll
                    for (int n = 3; n >= 0; --n) {
                        float z[4], sp[4]; bool va[4];
#pragma unroll
                        for (int j = 0; j < 4; ++j) { const int key = kbase + 16 * n + 4 * fq + j; va[j] = key < qi; z[j] = s[n][mb][j] * SM_SCALE; sp[j] = va[j] ? softplus_f(z[j]) : 0.f; }
                        const float e2 = sp[3], e1 = e2 + sp[2], e0 = e1 + sp[1], tot = e0 + sp[0];
                        const float partner = __shfl_xor(tot, 16); const float a2 = tot + partner; const float b2 = __shfl_xor(a2, 32);
                        const float higher = ((fq & 1) == 0 ? partner : 0.f) + ((fq & 2) == 0 ? b2 : 0.f);
                        const float base = R[mb] + higher;
                        const float tl[4] = {base + e0, base + e1, base + e2, base};
#pragma unroll
                        for (int j = 0; j < 4; ++j) s[n][mb][j] = va[j] ? __expf(z[j] - sp[j] - tl[j]) : 0.f;
                        R[mb] += a2 + b2;
                    }
                } else {
                    float bm = -1e30f; bool va[4][4];
#pragma unroll
                    for (int n = 0; n < 4; ++n)
#pragma unroll
                        for (int j = 0; j < 4; ++j) { const int dist = qi - (kbase + 16 * n + 4 * fq + j); va[n][j] = (dist >= 0) && (dist <= 128); bm = fmaxf(bm, va[n][j] ? s[n][mb][j] : -1e30f); }
                    bm = fmaxf(bm, __shfl_xor(bm, 16)); bm = fmaxf(bm, __shfl_xor(bm, 32));
                    const float mnew = fmaxf(mrun[mb], bm), alpha = __expf(mrun[mb] - mnew);
                    float ps = 0.f;
#pragma unroll
                    for (int n = 0; n < 4; ++n)
#pragma unroll
                        for (int j = 0; j < 4; ++j) { const float pv = va[n][j] ? __expf(s[n][mb][j] - mnew) : 0.f; s[n][mb][j] = pv; ps += pv; }
                    lrun[mb] = lrun[mb] * alpha + ps; mrun[mb] = mnew;
#pragma unroll
                    for (int c = 0; c < 8; ++c) o[c][mb] = o[c][mb] * alpha;
                }
                pf[mb][0] = pack_frag(s[0][mb], s[1][mb]); pf[mb][1] = pack_frag(s[2][mb], s[3][mb]);
            }
#pragma unroll
            for (int c = 0; c < 8; ++c)
#pragma unroll
                for (int s2 = 0; s2 < 2; ++s2) { const bf16x8 vf = frag_tr_alt(lds + A_VOFF, KVS, 32 * s2, 16 * c, lane);
#pragma unroll
                    for (int mb = 0; mb < MB; ++mb) o[c][mb] = mma(vf, pf[mb][s2], o[c][mb]); }
            if (SBM) { float rm = fminf(R[0], R[MB - 1]);
                rm = fminf(rm, __shfl_xor(rm, 1)); rm = fminf(rm, __shfl_xor(rm, 2)); rm = fminf(rm, __shfl_xor(rm, 4)); rm = fminf(rm, __shfl_xor(rm, 8));
                if (lane == 0) flag[w] = rm; }
        }
    }
#undef ATT_LOAD
    __syncthreads();
#pragma unroll
    for (int mb = 0; mb < MB; ++mb) {
        const int qi = q0 + 16 * mb + fr;
        const size_t grow = rowbase + (SBM ? (size_t)qi : (size_t)qi * r + p);
        if (SBM) {
            const bf16_t* gp = PJ + pjo(96 + h, grow) + 4 * fq; bf16_t* op = PJ + pjo(h, grow) + 4 * fq;
#pragma unroll
            for (int c = 0; c < 8; ++c) { const u32x2 gw = *(const u32x2*)(gp + 16 * c);
                u32x2 ow; ow.x = cvtpk(o[c][mb][0] * silu_f(bflo(gw.x)), o[c][mb][1] * silu_f(bfhi(gw.x))); ow.y = cvtpk(o[c][mb][2] * silu_f(bflo(gw.y)), o[c][mb][3] * silu_f(bfhi(gw.y)));
                *(u32x2*)(op + 16 * c) = ow; }
        } else {
            float l = lrun[mb]; l += __shfl_xor(l, 16); l += __shfl_xor(l, 32);
            const float inv = 1.0f / l;
            bf16_t* op = OG + ((size_t)(g * 16 + h) * MH + grow) * 128 + 4 * fq;
#pragma unroll
            for (int c = 0; c < 8; ++c) { u32x2 ow; ow.x = cvtpk(o[c][mb][0] * inv, o[c][mb][1] * inv); ow.y = cvtpk(o[c][mb][2] * inv, o[c][mb][3] * inv); *(u32x2*)(op + 16 * c) = ow; }
            if (fq == 0) LSE[(size_t)(g * 16 + h) * MH + grow] = mrun[mb] + __logf(l);
        }
    }
}

__device__ __forceinline__ void attn_phase(LAS unsigned char* lds, bf16_t* PJ, const float* qg, const float* kg, bf16_t* OG, float* LSE) {
    const int wg = blockIdx.x;
    for (int j = 0; j < 2; ++j) {
        for (int pair = wg; pair < 256; pair += gridDim.x) {
            const int bl = pair >> 7, h = (pair >> 3) & 15, qh = pair & 7, qt = j == 0 ? 15 - qh : qh;
            attn_item<true>(lds, PJ, bl, h, qt, 1, 0, 0, qg, kg, OG, LSE);
        }
    }
    for (int id = wg; id < 2 * 16 * 96; id += gridDim.x) {
        const int bh = id / 96, rem = id % 96, bl = bh >> 4, h = bh & 15;
        int g, r, p, n;
        if (rem < 32) { g = 0; r = 1; p = 0; n = rem; }
        else if (rem < 64) { g = 1; r = 4; p = (rem - 32) >> 3; n = (rem - 32) & 7; }
        else { g = 2; r = 16; p = (rem - 64) >> 1; n = (rem - 64) & 1; }
        attn_item<false>(lds, PJ, bl, h, n, r, p, g, qg, kg, OG, LSE);
    }
}
__device__ __forceinline__ void combine_phase(bf16_t* PJ, const bf16_t* OG, const float* LSE) {
    const size_t total = (size_t)16 * MH * 16, stride = (size_t)gridDim.x * 512;
    for (size_t id = (size_t)blockIdx.x * 512 + opaque_tid(); id < total; id += stride) {
        const int ch = (int)(id & 15); const size_t hr = id >> 4; const int h = (int)(hr / MH); const size_t row = hr % MH;
        const float l0 = LSE[hr], l1 = LSE[(size_t)16 * MH + hr], l2 = LSE[(size_t)32 * MH + hr];
        const float mx = fmaxf(l0, fmaxf(l1, l2)); float w0 = __expf(l0 - mx), w1 = __expf(l1 - mx), w2 = __expf(l2 - mx);
        const float inv = 1.0f / (w0 + w1 + w2); w0 *= inv; w1 *= inv; w2 *= inv;
        float a[8], b[8], c[8], gt[8], o[8];
        unpack8(*(const u32x4*)(OG + hr * 128 + 8 * ch), a);
        unpack8(*(const u32x4*)(OG + ((size_t)16 * MH + hr) * 128 + 8 * ch), b);
        unpack8(*(const u32x4*)(OG + ((size_t)32 * MH + hr) * 128 + 8 * ch), c);
        unpack8(*(const u32x4*)(PJ + pjo(112 + h, row) + 8 * ch), gt);
#pragma unroll
        for (int e = 0; e < 8; ++e) o[e] = (w0 * a[e] + w1 * b[e] + w2 * c[e]) * silu_f(gt[e]);
        *(u32x4*)(PJ + pjo(16 + h, row) + 8 * ch) = pack8(o);
    }
}

constexpr int H_LF = 0, H_CUM = 32768, H_QT = 65536, H_KT = H_QT + 64 * KVS, H_VT = H_KT + 64 * KVS, H_SBT = H_VT + 64 * 80, H_PS = H_SBT + 32 * KVS, H_END = H_PS + 2048;
constexpr int VTS = 80;
static_assert(H_END <= 131072, "hgrn lds");
__device__ __forceinline__ void hgrn_item(LAS unsigned char* lds, const bf16_t* PJ, bf16_t* O1, const float* lbl, int bl, int h, int vp) {
    const int tid = opaque_tid(), lane = tid & 63, w = __builtin_amdgcn_readfirstlane(tid >> 6), fr = lane & 15, fq = lane >> 4;
    LAS float* LF = (LAS float*)(lds + H_LF); LAS float* CUM = (LAS float*)(lds + H_CUM);
    const int ch = tid & 15, c0 = 8 * ch;
    float lbv[8], oml[8];
#pragma unroll
    for (int e = 0; e < 8; ++e) { const float d = lbl[DI + h * 128 + c0 + e] - lbl[h * 128 + c0 + e]; lbv[e] = 1.0f / (1.0f + __expf(-d)); oml[e] = 1.0f - lbv[e]; }
    f32x4 S[2] = {(f32x4){0.f, 0.f, 0.f, 0.f}, (f32x4){0.f, 0.f, 0.f, 0.f}};
    const size_t rowbase = (size_t)bl * SEQ;
    const int tb = w >> 1, vb = w & 1;
    LAS float* PS = (LAS float*)(lds + H_PS);
    u32x4 qn[2], fn[2], vn = (u32x4){0u, 0u, 0u, 0u};
#define HG_LOAD(ckx) do { const size_t rr_ = rowbase + (size_t)(ckx) * 64; \
        _Pragma("unroll") for (int i = 0; i < 2; ++i) { const size_t ro_ = rr_ + (tid >> 4) + 32 * i; qn[i] = *(const u32x4*)(PJ + pjo(h, ro_) + c0); fn[i] = *(const u32x4*)(PJ + pjo(32 + h, ro_) + c0); } \
        if (tid < 256) vn = *(const u32x4*)(PJ + pjo(64 + h, rr_ + (tid >> 2)) + vp * 32 + 8 * (tid & 3)); } while (0)
    HG_LOAD(0);
    for (int ck = 0; ck < SEQ / 64; ++ck) {
        const size_t r0 = rowbase + (size_t)ck * 64;
        u32x4 qraw[2]; float kk[2][8];
        const u32x4 vraw = vn;
#pragma unroll
        for (int i = 0; i < 2; ++i) {
            const int t = (tid >> 4) + 32 * i;
            qraw[i] = qn[i];
            float fp[8]; unpack8(fn[i], fp);
            float lf[8];
#pragma unroll
            for (int e = 0; e < 8; ++e) { const float sg = 1.0f / (1.0f + __expf(-fp[e])); const float f = lbv[e] + oml[e] * sg; lf[e] = __logf(f); kk[i][e] = oml[e] * (1.0f - sg); }
            *(LAS f32x4*)(LF + t * 128 + c0) = (f32x4){lf[0], lf[1], lf[2], lf[3]};
            *(LAS f32x4*)(LF + t * 128 + c0 + 4) = (f32x4){lf[4], lf[5], lf[6], lf[7]};
        }
        if (ck + 1 < SEQ / 64) HG_LOAD(ck + 1);
        __syncthreads();
        { const int c = tid & 127, qr = tid >> 7; float run[16];
#pragma unroll
            for (int i = 0; i < 16; ++i) run[i] = LF[(16 * qr + i) * 128 + c];
#pragma unroll
            for (int i = 1; i < 16; ++i) run[i] += run[i - 1];
            PS[qr * 128 + c] = run[15];
            __syncthreads();
            float off = 0.f;
#pragma unroll
            for (int q2 = 0; q2 < 3; ++q2) { const float pv = PS[q2 * 128 + c]; off += (q2 < qr) ? pv : 0.f; }
#pragma unroll
            for (int i = 0; i < 16; ++i) CUM[(16 * qr + i) * 128 + c] = run[i] + off; }
        __syncthreads();
        { const f32x4 m0 = *(LAS f32x4*)(CUM + 31 * 128 + c0), m1 = *(LAS f32x4*)(CUM + 31 * 128 + c0 + 4);
            const float cm[8] = {m0.x, m0.y, m0.z, m0.w, m1.x, m1.y, m1.z, m1.w};
#pragma unroll
            for (int i = 0; i < 2; ++i) {
                const int t = (tid >> 4) + 32 * i;
                const f32x4 u0 = *(LAS f32x4*)(CUM + t * 128 + c0), u1 = *(LAS f32x4*)(CUM + t * 128 + c0 + 4);
                const float cu[8] = {u0.x, u0.y, u0.z, u0.w, u1.x, u1.y, u1.z, u1.w};
                float q[8], qt[8], kt[8]; unpack8(qraw[i], q);
#pragma unroll
                for (int e = 0; e < 8; ++e) { const float d = cu[e] - cm[e]; qt[e] = q[e] * __expf(d); kt[e] = kk[i][e] * __expf(-d); }
                *(LAS u32x4*)(lds + H_QT + t * KVS + ch * 16) = pack8(qt);
                *(LAS u32x4*)(lds + H_KT + t * KVS + ch * 16) = pack8(kt);
            }
            if (tid < 256) *(LAS u32x4*)(lds + H_VT + (tid >> 2) * VTS + (tid & 3) * 16) = vraw;
            const f32x4 cs = *(LAS f32x4*)(CUM + 31 * 128 + 16 * w + 4 * fq);
#pragma unroll
            for (int v2 = 0; v2 < 2; ++v2) { u32x2 sw; sw.x = cvtpk(S[v2][0] * __expf(cs.x), S[v2][1] * __expf(cs.y)); sw.y = cvtpk(S[v2][2] * __expf(cs.z), S[v2][3] * __expf(cs.w));
                *(LAS u32x2*)(lds + H_SBT + (fr + 16 * v2) * KVS + (16 * w + 4 * fq) * 2) = sw; }
        }
        __syncthreads();
        {
            bf16x8 qtf[4];
#pragma unroll
            for (int ks = 0; ks < 4; ++ks) qtf[ks] = frag_row(lds + H_QT, KVS, 16 * tb, 32 * ks, lane);
            f32x4 out = (f32x4){0.f, 0.f, 0.f, 0.f};
#pragma unroll
            for (int ks = 0; ks < 4; ++ks) out = mma(frag_row(lds + H_SBT, KVS, 16 * vb, 32 * ks, lane), qtf[ks], out);
            f32x4 at[4];
#pragma unroll
            for (int sb = 0; sb < 4; ++sb) {
                at[sb] = (f32x4){0.f, 0.f, 0.f, 0.f};
                if (sb <= tb) {
#pragma unroll
                    for (int ks = 0; ks < 4; ++ks) at[sb] = mma(frag_row(lds + H_KT, KVS, 16 * sb, 32 * ks, lane), qtf[ks], at[sb]);
                    if (sb == tb) {
#pragma unroll
                        for (int j = 0; j < 4; ++j) if (4 * fq + j > fr) at[sb][j] = 0.f;
                    }
                }
            }
#pragma unroll
            for (int s2 = 0; s2 < 2; ++s2) if (2 * s2 <= tb) out = mma(frag_tr_alt(lds + H_VT, VTS, 32 * s2, 16 * vb, lane), pack_frag(at[2 * s2], at[2 * s2 + 1]), out);
            u32x2 ow; ow.x = cvtpk(out[0], out[1]); ow.y = cvtpk(out[2], out[3]);
            *(u32x2*)(O1 + ((size_t)h * MH + r0 + 16 * tb + fr) * 128 + vp * 32 + 16 * vb + 4 * fq) = ow;
            const f32x4 cl = *(LAS f32x4*)(CUM + 63 * 128 + 16 * w + 4 * fq), cmm = *(LAS f32x4*)(CUM + 31 * 128 + 16 * w + 4 * fq);
            const bf16x8 kf0 = frag_tr(lds + H_KT, KVS, 0, 16 * w, lane), kf1 = frag_tr(lds + H_KT, KVS, 32, 16 * w, lane);
#pragma unroll
            for (int v2 = 0; v2 < 2; ++v2) {
                f32x4 U = (f32x4){0.f, 0.f, 0.f, 0.f};
                U = mma(kf0, frag_tr(lds + H_VT, VTS, 0, 16 * v2, lane), U);
                U = mma(kf1, frag_tr(lds + H_VT, VTS, 32, 16 * v2, lane), U);
#pragma unroll
                for (int j = 0; j < 4; ++j) S[v2][j] = __expf(cl[j]) * S[v2][j] + __expf(cl[j] - cmm[j]) * U[j];
            }
        }
    }
#undef HG_LOAD
    __syncthreads();
}
__device__ __forceinline__ void hgrn_post(bf16_t* PJ, const bf16_t* O1, const float* og) {
    const size_t total = (size_t)32 * MH * 16, stride = (size_t)gridDim.x * 512;
    const int tid = opaque_tid(); const int ch = tid & 15;
    const f32x4 g0 = *(const f32x4*)(og + 8 * ch), g1 = *(const f32x4*)(og + 8 * ch + 4);
    const float gg[8] = {g0.x, g0.y, g0.z, g0.w, g1.x, g1.y, g1.z, g1.w};
    for (size_t id = (size_t)blockIdx.x * 512 + tid; id < total; id += stride) {
        const size_t hr = id >> 4; const int h = (int)(hr / MH); const size_t row = hr % MH;
        float o[8], gt[8]; unpack8(*(const u32x4*)(O1 + hr * 128 + 8 * ch), o); unpack8(*(const u32x4*)(PJ + pjo(96 + h, row) + 8 * ch), gt);
        float ss = 0.f;
#pragma unroll
        for (int e = 0; e < 8; ++e) ss += o[e] * o[e];
        ss += __shfl_xor(ss, 1); ss += __shfl_xor(ss, 2); ss += __shfl_xor(ss, 4); ss += __shfl_xor(ss, 8);
        const float rs = rsqrtf(ss * (1.f / 128.f) + RMS_EPS);
#pragma unroll
        for (int e = 0; e < 8; ++e) o[e] = o[e] * rs * gg[e] * silu_f(gt[e]);
        *(u32x4*)(PJ + pjo(h, row) + 8 * ch) = pack8(o);
    }
}


#define XB_TMO      128
#define XB_XCNT(j)  (256  + 64 * (j))
#define XB_XSUB(j)  (1280 + 64 * (j))
#define XB_XGEN(j)  (2304 + 64 * (j))
#define XB_TOP      3328
#define XB_TOPGEN   3392
#define XCD_BAR_WORDS 3456
#define XB_SPIN_CAP (1u << 20)
__device__ __forceinline__ unsigned xb_ld(unsigned* p)              { return __hip_atomic_load(p, __ATOMIC_RELAXED, __HIP_MEMORY_SCOPE_AGENT); }
__device__ __forceinline__ unsigned xb_add(unsigned* p, unsigned v) { return __hip_atomic_fetch_add(p, v, __ATOMIC_RELAXED, __HIP_MEMORY_SCOPE_AGENT); }
__device__ __forceinline__ unsigned xb_xcc_id() { return (unsigned)__builtin_amdgcn_s_getreg((3 << 11) | 20) & 0xFu; }
#define XB_SPIN(cond, bar) do { unsigned _sp = 0; while (cond) { __builtin_amdgcn_s_sleep(1); \
    if ((++_sp & 255u) == 0u) { if (xb_ld(&(bar)[XB_TMO])) break; if (_sp > XB_SPIN_CAP) { atomicAdd(&(bar)[XB_TMO], 1u); break; } } } } while (0)
struct XcdBarrier { unsigned* bar; unsigned x; volatile LAS unsigned* st; };
__device__ __forceinline__ XcdBarrier xcd_barrier_post(unsigned* bar, volatile LAS unsigned* st) {
    XcdBarrier b; b.bar = bar; b.x = xb_xcc_id(); b.st = st;
    if (threadIdx.x == 0) (void)xb_add(&bar[XB_XCNT(b.x)], 1u);
    return b;
}
__device__ __forceinline__ void xcd_barrier_complete(unsigned* bar, unsigned x, unsigned& nloc, unsigned& nx) {
    const unsigned G = gridDim.x * gridDim.y * gridDim.z;
    unsigned sum, cnt, mine, sp = 0u;
    for (;;) {
        sum = 0u; cnt = 0u; mine = 0u;
#pragma unroll
        for (unsigned j = 0; j < 16; ++j) { const unsigned c = xb_ld(&bar[XB_XCNT(j)]); sum += c; cnt += (c > 0u) ? 1u : 0u; mine = (j == x) ? c : mine; }
        if (sum == G) break;
        __builtin_amdgcn_s_sleep(1);
        if ((++sp & 255u) == 0u) { if (xb_ld(&bar[XB_TMO])) break; if (sp > XB_SPIN_CAP) { atomicAdd(&bar[XB_TMO], 1u); break; } }
    }
    nloc = mine > 0u ? mine : 1u; nx = cnt > 0u ? cnt : 1u;
}
__device__ __forceinline__ void xcd_barrier(const XcdBarrier& b) {
    asm volatile("s_waitcnt vmcnt(0)" ::: "memory");
    __syncthreads();
    if (threadIdx.x == 0) {
        unsigned* bar = b.bar;
        __builtin_amdgcn_s_waitcnt(0);
        unsigned nloc = b.st[0], nx = b.st[1];
        if (nloc == 0u) { xcd_barrier_complete(bar, b.x, nloc, nx); b.st[0] = nloc; b.st[1] = nx; }
        const unsigned old = xb_add(&bar[XB_XSUB(b.x)], 1u);
        const unsigned gen = old / nloc;
        if (old + 1u == (gen + 1u) * nloc) {
            __builtin_amdgcn_fence(__ATOMIC_RELEASE, "agent");
            asm volatile("s_waitcnt vmcnt(0)" ::: "memory");
            const unsigned og = xb_add(&bar[XB_TOP], 1u);
            const unsigned tg = og / nx;
            if (og + 1u == (tg + 1u) * nx) xb_add(&bar[XB_TOPGEN], 1u);
            else XB_SPIN(xb_ld(&bar[XB_TOPGEN]) == tg, bar);
            __builtin_amdgcn_fence(__ATOMIC_ACQUIRE, "agent");
            xb_add(&bar[XB_XGEN(b.x)], 1u);
            asm volatile("s_waitcnt vmcnt(0)" ::: "memory");
        } else {
            XB_SPIN(xb_ld(&bar[XB_XGEN(b.x)]) == gen, bar);
            __builtin_amdgcn_fence(__ATOMIC_ACQUIRE, "agent");
            asm volatile("s_waitcnt vmcnt(0)" ::: "memory");
        }
    }
    __syncthreads();
}

struct Args { const float* in[11]; float* out; unsigned char* ws; unsigned long long pad; };

__global__ void __launch_bounds__(512, 2) fwd(Args a) {
    extern __shared__ __attribute__((aligned(16))) unsigned char lds_raw[];
    LAS unsigned char* lds = (LAS unsigned char*)lds_raw;
    cg::grid_group grid = cg::this_grid();
    const float* x = a.in[0]; const float* norm_even = a.in[1]; const float* w_in_even = a.in[2]; const float* qg = a.in[3]; const float* kg = a.in[4];
    const float* w_out_even = a.in[5]; const float* norm_odd = a.in[6]; const float* w_in_odd = a.in[7]; const float* lbl = a.in[8]; const float* og = a.in[9]; const float* w_out_odd = a.in[10];
    bf16_t* WinT = (bf16_t*)(a.ws + WS_WIN); bf16_t* WoT = (bf16_t*)(a.ws + WS_WO); bf16_t* XN = (bf16_t*)(a.ws + WS_XN); bf16_t* PJ = (bf16_t*)(a.ws + WS_PJ);
    bf16_t* OG = (bf16_t*)(a.ws + WS_OG); float* LSE = (float*)(a.ws + WS_LSE);
    float* out = a.out;
    volatile LAS unsigned* bst = (volatile LAS unsigned*)(lds + LDS_BYTES - 64);
    if (threadIdx.x < 2) bst[threadIdx.x] = 0u;
    __syncthreads();
    const XcdBarrier xbar = xcd_barrier_post((unsigned*)a.ws, bst);
#define GSYNC() xcd_barrier(xbar)

#ifdef PROBE_SEL
    unsigned long long tprev = __builtin_amdgcn_s_memrealtime(), tacc = 0ull;
#define STAMP(kind) do { const unsigned long long now_ = __builtin_amdgcn_s_memrealtime(); if ((PROBE_SEL >> ((kind) + 8 * layer)) & 1) tacc += now_ - tprev; tprev = now_; } while (0)
#else
#define STAMP(kind) do { } while (0)
#endif
    for (int layer = 0; layer < 2; ++layer) {
        prologue(lds, layer == 0 ? x : out, layer == 0 ? norm_even : norm_odd, layer == 0 ? w_in_even : w_in_odd, layer == 0 ? w_out_even : w_out_odd, WinT, WoT, XN);
        if (layer == 0) grid.sync(); else GSYNC();
        STAMP(0);
        for (int half = 0; half < 2; ++half) {
            { pg8::Gemm g{XN + (size_t)half * MH * DM, WinT, MH, NC, DM, DM, 5, 0}; pg8::StaticOrder S; S.init(MH, NC, gridDim.x, blockIdx.x);
              pg8::EpiBf16 E{PJ, NC}; pg8::gemm_phase<pg8::EpiBf16>(lds, g, S, E); }
            GSYNC(); STAMP(1);
            if (layer == 0) {
                attn_phase(lds, PJ, qg, kg, OG, LSE);
                GSYNC(); STAMP(2);
                combine_phase(PJ, OG, LSE);
            } else {
                for (int it = blockIdx.x; it < 256; it += gridDim.x) hgrn_item(lds, PJ, OG, lbl, it >> 7, (it >> 2) & 31, it & 3);
                GSYNC(); STAMP(2);
                hgrn_post(PJ, OG, og);
            }
            GSYNC(); STAMP(3);
            { pg8::Gemm g{PJ, WoT, MH, DM, DI, 128, 1, (size_t)MH * 256}; pg8::StaticOrder S; S.init(MH, DM, gridDim.x, blockIdx.x);
              const float* res = (layer == 0 ? x : out) + (size_t)half * MH * DM;
              pg8::EpiRes E{res, out + (size_t)half * MH * DM, DM}; pg8::gemm_phase<pg8::EpiRes>(lds, g, S, E); }
            if (layer == 0 || half == 0) GSYNC();
            STAMP(4);
        }
    }
#ifdef PROBE_SEL
    if (blockIdx.x == 0) { const int K = (int)(tacc / 100ull); for (int i = threadIdx.x; i < K; i += 512) out[i] += 0.125f; }
#endif
}

extern "C" void kernel_launch(void* const* d_in, const int* in_sizes, int n_in, void* d_out, int out_size, void* d_ws, size_t ws_size, hipStream_t stream) {
    static int grid = 0;
    if (grid == 0) {
        if (n_in != 11 || out_size != MTOK * DM || ws_size < WS_END) { fprintf(stderr, "kernel_launch: unexpected shapes (n_in %d out %d ws %zu)\n", n_in, out_size, ws_size); grid = -1; return; }
        int dev = 0, cus = 0, per_cu = 0;
        (void)hipGetDevice(&dev);
        (void)hipDeviceGetAttribute(&cus, hipDeviceAttributeMultiprocessorCount, dev);
        (void)hipFuncSetAttribute((const void*)fwd, hipFuncAttributeMaxDynamicSharedMemorySize, LDS_BYTES);
        (void)hipOccupancyMaxActiveBlocksPerMultiprocessor(&per_cu, (const void*)fwd, 512, LDS_BYTES);
        (void)hipGetLastError();
        grid = cus > 0 ? cus : 256;
    }
    if (grid < 0) return;
    (void)hipMemsetAsync(d_ws, 0, 16384, stream);
    Args a{};
    for (int i = 0; i < 11; ++i) a.in[i] = (const float*)d_in[i];
    a.out = (float*)d_out; a.ws = (unsigned char*)d_ws;
    void* args[] = {&a};
    hipError_t e = hipLaunchCooperativeKernel((const void*)fwd, dim3(grid), dim3(512), args, LDS_BYTES, stream);
    if (e != hipSuccess) fprintf(stderr, "cooperative launch failed: %s\n", hipGetErrorString(e));
}
```

```cpp
#include <hip/hip_runtime.h>
#include <hip/hip_cooperative_groups.h>
#include <cstdio>
namespace cg = cooperative_groups;

#define LAS __attribute__((address_space(3)))
typedef unsigned short bf16_t;
typedef short bf16x8 __attribute__((ext_vector_type(8)));
typedef short s16x4 __attribute__((ext_vector_type(4)));
typedef float f32x4 __attribute__((ext_vector_type(4)));
typedef float f32x2_t __attribute__((ext_vector_type(2)));
typedef __bf16 bf16x2_t __attribute__((ext_vector_type(2)));
typedef unsigned u32x4 __attribute__((ext_vector_type(4)));
typedef unsigned u32x2 __attribute__((ext_vector_type(2)));

constexpr int SEQ = 4096, DM = 2048, NC = 16384, DI = 4096, MTOK = 16384, MH = 8192;
constexpr float RMS_EPS = 1e-6f;
constexpr size_t MiB = 1u << 20;
constexpr size_t WS_WIN = 1 * MiB, WS_WO = 65 * MiB, WS_XN = 81 * MiB, WS_PJ = 145 * MiB, WS_OG = 401 * MiB, WS_LSE = 497 * MiB, WS_END = 499 * MiB;
constexpr int LDS_BYTES = 147456;

__device__ __forceinline__ unsigned cvtpk(float lo, float hi) { f32x2_t v = {lo, hi}; bf16x2_t b = __builtin_convertvector(v, bf16x2_t); return __builtin_bit_cast(unsigned, b); }
__device__ __forceinline__ float bflo(unsigned w) { return __uint_as_float(w << 16); }
__device__ __forceinline__ float bfhi(unsigned w) { return __uint_as_float(w & 0xffff0000u); }
__device__ __forceinline__ void unpack8(const u32x4 w, float* f) { f[0] = bflo(w.x); f[1] = bfhi(w.x); f[2] = bflo(w.y); f[3] = bfhi(w.y); f[4] = bflo(w.z); f[5] = bfhi(w.z); f[6] = bflo(w.w); f[7] = bfhi(w.w); }
__device__ __forceinline__ u32x4 pack8(const float* f) { u32x4 w; w.x = cvtpk(f[0], f[1]); w.y = cvtpk(f[2], f[3]); w.z = cvtpk(f[4], f[5]); w.w = cvtpk(f[6], f[7]); return w; }
__device__ __forceinline__ float silu_f(float g) { return g / (1.0f + __expf(-g)); }
__device__ __forceinline__ float softplus_f(float z) { return fmaxf(z, 0.f) + __logf(1.0f + __expf(-fabsf(z))); }

__device__ __forceinline__ int opaque_tid() { int t = threadIdx.x; asm volatile("" : "+v"(t)); return t; }

__device__ __forceinline__ size_t pjo(int hg, size_t row) { return ((size_t)hg * MH + row) * 128; }

__device__ __forceinline__ bf16x8 frag_row(LAS const unsigned char* tile, int stride, int r0, int k0, int lane) {
    return *(LAS const bf16x8*)(tile + (r0 + (lane & 15)) * stride + (k0 + 8 * (lane >> 4)) * 2);
}
__device__ __forceinline__ s16x4 tr4(LAS const unsigned char* p) { return __builtin_bit_cast(s16x4, __builtin_amdgcn_ds_read_tr16_b64_v4i16((LAS s16x4*)p)); }
__device__ __forceinline__ bf16x8 frag_tr(LAS const unsigned char* tile, int stride, int k0, int n0, int lane) {
    const int g = lane >> 4, q = (lane & 15) >> 2, p = lane & 3;
    LAS const unsigned char* a = tile + (k0 + 8 * g + q) * stride + (n0 + 4 * p) * 2;
    const s16x4 lo = tr4(a), hi = tr4(a + 4 * stride);
    return (bf16x8){lo[0], lo[1], lo[2], lo[3], hi[0], hi[1], hi[2], hi[3]};
}
__device__ __forceinline__ bf16x8 frag_tr_alt(LAS const unsigned char* tile, int stride, int k0, int n0, int lane) {
    const int g = lane >> 4, q = (lane & 15) >> 2, p = lane & 3;
    LAS const unsigned char* a = tile + (k0 + 4 * g + q) * stride + (n0 + 4 * p) * 2;
    const s16x4 lo = tr4(a), hi = tr4(a + 16 * stride);
    return (bf16x8){lo[0], lo[1], lo[2], lo[3], hi[0], hi[1], hi[2], hi[3]};
}
__device__ __forceinline__ f32x4 mma(bf16x8 a, bf16x8 b, f32x4 c) { return __builtin_amdgcn_mfma_f32_16x16x32_bf16(a, b, c, 0, 0, 0); }
__device__ __forceinline__ bf16x8 pack_frag(const f32x4 lo, const f32x4 hi) {
    u32x4 w; w.x = cvtpk(lo[0], lo[1]); w.y = cvtpk(lo[2], lo[3]); w.z = cvtpk(hi[0], hi[1]); w.w = cvtpk(hi[2], hi[3]);
    return __builtin_bit_cast(bf16x8, w);
}

namespace pg8 {
constexpr int BM = 256, BK = 64, HALF = 128, HTB = HALF * BK * 2, STAGE_BYTES = 8 * HTB, NXCD = 8, WGM = 8;
__device__ __forceinline__ int lds_byte(int r, int c) { const int st = (r >> 4) * 2 + (c >> 5), rr = r & 15, cc = c & 31, ob = rr * 64 + cc * 2; return st * 1024 + (ob ^ (((ob >> 9) & 1) << 5)); }
__device__ __forceinline__ void stage_rc(int b, int& R, int& C) { const int st = b / 1024, sb = b % 1024, swz = sb ^ (((sb >> 9) & 1) << 5); R = (st >> 1) * 16 + swz / 64; C = (st & 1) * 32 + (swz % 64) / 2; }
__device__ __forceinline__ int perm32(int rho) { const int n = rho >> 4, i = rho & 15; return 8 * (i >> 2) + 4 * n + (i & 3); }
struct Unit { int pm, pn; };
struct Gemm { const bf16_t* A; const bf16_t* Bt; int M, N, K, lda, ksh; size_t kbig; };
struct StaticOrder {
    int nM, nN, nwg, G, c;
    __device__ void init(int M, int N, int G_, int c_) { nM = M / BM; nN = N / BM; nwg = nM * nN; G = G_; c = c_; }
    __device__ bool next(int i, Unit& u) const {
        const long L = (long)i * G + c; if (L >= nwg) return false;
        int wgid = (int)L; { const int q = nwg / NXCD, r = nwg % NXCD, xcd = wgid % NXCD, off = wgid / NXCD; wgid = (xcd < r ? xcd * (q + 1) : r * (q + 1) + (xcd - r) * q) + off; }
        const int nig = WGM * nN, gid = wgid / nig, fm = gid * WGM, gsz = (nM - fm) < WGM ? (nM - fm) : WGM;
        u.pm = fm + ((wgid % nig) % gsz); u.pn = (wgid % nig) / gsz; return true;
    }
};
struct EpiBf16 {
    static constexpr bool PERM = true;
    bf16_t* O; int ldc;
    __device__ __forceinline__ void operator()(const f32x4 (&acc)[2][2][4][2], const Unit& u, int wr, int wc, int fr, int fq) const {
        const int row0 = u.pm * BM + wr * 64 + fr, d0 = wc * 32 + 8 * fq;
#pragma unroll
        for (int ai = 0; ai < 2; ++ai)
#pragma unroll
            for (int m = 0; m < 4; ++m) {
#pragma unroll
                for (int bj = 0; bj < 2; ++bj) { const f32x4 v0 = acc[ai][bj][m][0], v1 = acc[ai][bj][m][1];
                    u32x4 w; w.x = cvtpk(v0[0], v0[1]); w.y = cvtpk(v0[2], v0[3]); w.z = cvtpk(v1[0], v1[1]); w.w = cvtpk(v1[2], v1[3]);
                    *(u32x4*)(O + pjo(2 * u.pn + bj, (size_t)(row0 + ai * HALF + m * 16)) + d0) = w; } }
    }
};
struct EpiRes {
    static constexpr bool PERM = false;
    const float* R; float* C; int ldc;
    __device__ __forceinline__ void operator()(const f32x4 (&acc)[2][2][4][2], const Unit& u, int wr, int wc, int fr, int fq) const {
        const int row0 = u.pm * BM + wr * 64 + fr, col0 = u.pn * BM + wc * 32 + 4 * fq;
#pragma unroll
        for (int ai = 0; ai < 2; ++ai)
#pragma unroll
            for (int m = 0; m < 4; ++m) { const size_t ro = (size_t)(row0 + ai * HALF + m * 16) * ldc + col0;
#pragma unroll
                for (int bj = 0; bj < 2; ++bj)
#pragma unroll
                    for (int n = 0; n < 2; ++n) { const f32x4 r = *(const f32x4*)(R + ro + bj * HALF + n * 16); *(f32x4*)(C + ro + bj * HALF + n * 16) = acc[ai][bj][m][n] + r; } }
    }
};

template <class Epi>
__device__ __forceinline__ void gemm_phase(LAS unsigned char* lds, const Gemm g, const StaticOrder& S, const Epi& E) {
    const int tid = opaque_tid(), wid = __builtin_amdgcn_readfirstlane(tid >> 6), lane = tid & 63, wr = wid >> 2, wc = wid & 3, fr = lane & 15, fq = lane >> 4;
    const int K = g.K, nt = K / BK, lda = g.lda, ksh = g.ksh, kmask = (1 << g.ksh) - 1;
    unsigned voffA[2], voffB[2];
#pragma unroll
    for (int i = 0; i < 2; ++i) { int R, C; stage_rc(tid * 16 + i * 8192, R, C); const int Rb = Epi::PERM ? ((R & ~31) + perm32(R & 31)) : R;
        voffA[i] = (unsigned)(R * lda + C) * 2u; voffB[i] = (unsigned)(Rb * K + C) * 2u; }
    const size_t kstep = (size_t)(BK * 2);
    const size_t hstepA = (size_t)HALF * lda * 2, hstepB = (size_t)HALF * K * 2;
    const size_t tstepA = 2 * hstepA, tstepB = 2 * hstepB;
    const unsigned ldsw = (unsigned)wid * 1024u;
    const int aoff = lds_byte(wr * 64 + fr, fq * 8), boff = lds_byte(wc * 32 + fr, fq * 8);
#define PG8_SA(b, h) (((b) * 2 + (h)) * HTB)
#define PG8_SB(b, h) ((4 + (b) * 2 + (h)) * HTB)
#define PG8_STAGE(bufoff, gbase, voff) do { _Pragma("unroll") for (int _i = 0; _i < 2; ++_i) \
        __builtin_amdgcn_global_load_lds((const unsigned*)((const char*)(gbase) + (voff)[_i]), (LAS unsigned*)(lds + (bufoff) + ldsw + _i * 8192), 16, 0, 0); } while (0)
#define PG8_LDA(dst, b, h) do { _Pragma("unroll") for (int m = 0; m < 4; ++m) _Pragma("unroll") for (int k = 0; k < 2; ++k) dst[m][k] = *(const LAS bf16x8*)(lds + PG8_SA(b, h) + aoff + m * 2048 + k * 1024); } while (0)
#define PG8_LDB(dst, b, h) do { _Pragma("unroll") for (int n = 0; n < 2; ++n) _Pragma("unroll") for (int k = 0; k < 2; ++k) dst[n][k] = *(const LAS bf16x8*)(lds + PG8_SB(b, h) + boff + n * 2048 + k * 1024); } while (0)
#define PG8_MMA(ai, bj, At, Bt) do { __builtin_amdgcn_s_setprio(1); _Pragma("unroll") for (int m = 0; m < 4; ++m) _Pragma("unroll") for (int n = 0; n < 2; ++n) _Pragma("unroll") for (int k = 0; k < 2; ++k) \
        acc[ai][bj][m][n] = __builtin_amdgcn_mfma_f32_16x16x32_bf16(Bt[n][k], At[m][k], acc[ai][bj][m][n], 0, 0, 0); __builtin_amdgcn_s_setprio(0); } while (0)
#define PG8_WAIT_V(n) asm volatile("s_waitcnt vmcnt(" #n ")" ::: "memory")
#define PG8_WAIT_L(n) asm volatile("s_waitcnt lgkmcnt(" #n ")" ::: "memory")
#define PG8_BAR __builtin_amdgcn_s_barrier()
#define PG8_SCHED __builtin_amdgcn_sched_barrier(0)
    Unit cur, nxt; int ui = 0;
    if (!S.next(0, cur)) return;
    f32x4 acc[2][2][4][2];
#pragma unroll
    for (int a = 0; a < 2; ++a)
#pragma unroll
        for (int b = 0; b < 2; ++b)
#pragma unroll
            for (int m = 0; m < 4; ++m)
#pragma unroll
                for (int n = 0; n < 2; ++n) acc[a][b][m][n] = (f32x4){0.f, 0.f, 0.f, 0.f};
    bf16x8 At[4][2], B0[2][2], B1[2][2];
    const char* cA = (const char*)g.A + (size_t)cur.pm * tstepA; const char* cB = (const char*)g.Bt + (size_t)cur.pn * tstepB;
    PG8_STAGE(PG8_SB(0, 0), cB, voffB); PG8_STAGE(PG8_SA(0, 0), cA, voffA); PG8_STAGE(PG8_SB(0, 1), cB + hstepB, voffB); PG8_STAGE(PG8_SA(0, 1), cA + hstepA, voffA);
    if (wr == 1) PG8_BAR;
    PG8_WAIT_V(4); PG8_BAR;
    PG8_STAGE(PG8_SB(1, 0), cB + kstep, voffB); PG8_STAGE(PG8_SA(1, 0), cA + kstep, voffA); PG8_STAGE(PG8_SB(1, 1), cB + hstepB + kstep, voffB);
    PG8_WAIT_V(6); PG8_BAR;
    for (;;) {
        const bool has_next = S.next(ui + 1, nxt);
        const char* nA = has_next ? (const char*)g.A + (size_t)nxt.pm * tstepA : cA; const char* nB = has_next ? (const char*)g.Bt + (size_t)nxt.pn * tstepB : cB;
        for (int t = 0; t < nt; t += 2) {
            const bool last = (t == nt - 2);
            const char* a1 = cA + ((size_t)(t >> ksh) * g.kbig + (size_t)(t & kmask) * kstep) + kstep;
            const char* a2 = last ? nA : cA + ((size_t)((t + 2) >> ksh) * g.kbig + (size_t)((t + 2) & kmask) * kstep); const char* b2 = last ? nB : cB + (size_t)(t + 2) * kstep;
            const char* a3 = a2 + kstep; const char* b3 = b2 + kstep;
            PG8_LDB(B0, 0, 0); PG8_SCHED; PG8_LDA(At, 0, 0); PG8_STAGE(PG8_SA(1, 1), a1 + hstepA, voffA);
            PG8_WAIT_L(8); PG8_BAR; PG8_WAIT_L(0); PG8_MMA(0, 0, At, B0); PG8_BAR; PG8_SCHED;
            PG8_LDB(B1, 0, 1); PG8_STAGE(PG8_SB(0, 0), b2, voffB);
            PG8_BAR; PG8_WAIT_L(0); PG8_MMA(0, 1, At, B1); PG8_BAR;
            PG8_LDA(At, 0, 1); PG8_STAGE(PG8_SA(0, 0), a2, voffA);
            PG8_BAR; PG8_WAIT_L(0); PG8_MMA(1, 0, At, B0); PG8_BAR; PG8_SCHED;
            PG8_STAGE(PG8_SB(0, 1), b2 + hstepB, voffB);
            PG8_WAIT_V(6); PG8_BAR; PG8_MMA(1, 1, At, B1); PG8_BAR;
            PG8_LDB(B0, 1, 0); PG8_SCHED; PG8_LDA(At, 1, 0); PG8_STAGE(PG8_SA(0, 1), a2 + hstepA, voffA);
            PG8_WAIT_L(8); PG8_BAR; PG8_WAIT_L(0); PG8_MMA(0, 0, At, B0); PG8_BAR; PG8_SCHED;
            PG8_LDB(B1, 1, 1); PG8_STAGE(PG8_SB(1, 0), b3, voffB);
            PG8_BAR; PG8_WAIT_L(0); PG8_MMA(0, 1, At, B1); PG8_BAR;
            PG8_LDA(At, 1, 1); PG8_STAGE(PG8_SA(1, 0), a3, voffA);
            PG8_BAR; PG8_WAIT_L(0); PG8_MMA(1, 0, At, B0); PG8_BAR; PG8_SCHED;
            PG8_STAGE(PG8_SB(1, 1), b3 + hstepB, voffB);
            PG8_WAIT_V(6); PG8_BAR; PG8_MMA(1, 1, At, B1); PG8_BAR;
        }
        E(acc, cur, wr, wc, fr, fq);
        if (!has_next) break;
#pragma unroll
        for (int a = 0; a < 2; ++a)
#pragma unroll
            for (int b = 0; b < 2; ++b)
#pragma unroll
                for (int m = 0; m < 4; ++m)
#pragma unroll
                    for (int n = 0; n < 2; ++n) acc[a][b][m][n] = (f32x4){0.f, 0.f, 0.f, 0.f};
        cur = nxt; cA = nA; cB = nB; ++ui;
    }
    PG8_WAIT_V(0);
    if (wr == 0) PG8_BAR;
    PG8_BAR;
#undef PG8_SA
#undef PG8_SB
#undef PG8_STAGE
#undef PG8_LDA
#undef PG8_LDB
#undef PG8_MMA
#undef PG8_WAIT_V
#undef PG8_WAIT_L
#undef PG8_BAR
#undef PG8_SCHED
}
}

__device__ __forceinline__ float wave_sum(float v) {
#pragma unroll
    for (int o = 1; o < 64; o <<= 1) v += __shfl_xor(v, o);
    return v;
}
__device__ __forceinline__ void transpose_item(const float* __restrict__ W, int K, int N, bf16_t* __restrict__ WT, LAS float* scr, int item, int lane) {
    const int nblk = N / 32, kb = item / nblk, nb = item % nblk, k0 = 64 * kb, n0 = 32 * nb;
#pragma unroll 8
    for (int i = 0; i < 32; ++i) { const int kk = 2 * i + (lane >> 5); scr[kk * 33 + (lane & 31)] = W[(size_t)(k0 + kk) * N + n0 + (lane & 31)]; }
    asm volatile("s_waitcnt lgkmcnt(0)" ::: "memory");
    const int c = lane & 7;
#pragma unroll
    for (int j = 0; j < 4; ++j) { const int n = (lane >> 3) + 8 * j; const LAS float* s = scr + (8 * c) * 33 + n;
        u32x4 o; o.x = cvtpk(s[0 * 33], s[1 * 33]); o.y = cvtpk(s[2 * 33], s[3 * 33]); o.z = cvtpk(s[4 * 33], s[5 * 33]); o.w = cvtpk(s[6 * 33], s[7 * 33]);
        *(u32x4*)(WT + (size_t)(n0 + n) * K + k0 + 8 * c) = o; }
    asm volatile("s_waitcnt lgkmcnt(0)" ::: "memory");
}
__device__ __forceinline__ void rms_row_to_bf16(const float* xrow, const float* g, bf16_t* orow, int lane) {
    const f32x4* xr = (const f32x4*)xrow + lane; const f32x4* gr = (const f32x4*)g + lane;
    f32x4 v[8]; float s = 0.f;
#pragma unroll
    for (int j = 0; j < 8; ++j) { v[j] = xr[64 * j]; s += (v[j].x * v[j].x + v[j].y * v[j].y) + (v[j].z * v[j].z + v[j].w * v[j].w); }
    const float rstd = rsqrtf(wave_sum(s) * (1.f / DM) + RMS_EPS);
    u32x2* o8 = (u32x2*)orow + lane;
#pragma unroll
    for (int j = 0; j < 8; ++j) { const f32x4 gg = gr[64 * j]; u32x2 w; w.x = cvtpk(v[j].x * rstd * gg.x, v[j].y * rstd * gg.y); w.y = cvtpk(v[j].z * rstd * gg.z, v[j].w * rstd * gg.w); o8[64 * j] = w; }
}
__device__ __forceinline__ void prologue(LAS unsigned char* lds, const float* x, const float* ng, const float* w_in, const float* w_out, bf16_t* WinT, bf16_t* WoT, bf16_t* XN) {
    const int tid = opaque_tid(), lane = tid & 63, wave = tid >> 6;
    LAS float* scr = (LAS float*)(lds + wave * 16384);
    const int gw = blockIdx.x * 8 + wave, NGW = gridDim.x * 8;
    constexpr int I_IN = (DM / 64) * (NC / 32), I_OUT = (DI / 64) * (DM / 32);
    for (int it = gw; it < I_IN + I_OUT; it += NGW) {
        if (it < I_IN) transpose_item(w_in, DM, NC, WinT, scr, it, lane);
        else transpose_item(w_out, DI, DM, WoT, scr, it - I_IN, lane);
    }
    for (int m = gw; m < MTOK; m += NGW) rms_row_to_bf16(x + (size_t)m * DM, ng, XN + (size_t)m * DM, lane);
}

constexpr int KVS = 272;
constexpr int A_KOFF = 0, A_VOFF = 64 * KVS, A_FLAG = 2 * 64 * KVS;
constexpr float SB_STOP = 104.0f;
constexpr float SM_SCALE = 0.08838834764831845f;

template <bool SBM>
__device__ __forceinline__ void attn_item(LAS unsigned char* lds, bf16_t* PJ, int bl, int h, int qt_or_n, int r, int p, int g,
                                          const float* qg, const float* kg, bf16_t* OG, float* LSE) {
    constexpr int MB = SBM ? 2 : 1;
    const int tid = opaque_tid(), lane = tid & 63, w = __builtin_amdgcn_readfirstlane(tid >> 6), fr = lane & 15, fq = lane >> 4;
    const int hq = SBM ? h : 48 + h, hk = SBM ? 16 + h : 64 + h, hv = SBM ? 32 + h : 80 + h;
    const size_t rowbase = (size_t)bl * SEQ;
    const int q0 = SBM ? qt_or_n * 256 + 32 * w : qt_or_n * 128 + 16 * w;
    bf16x8 qf[MB][4];
#pragma unroll
    for (int mb = 0; mb < MB; ++mb) {
        const int qi = q0 + 16 * mb + fr;
        const size_t grow = rowbase + (SBM ? (size_t)qi : (size_t)qi * r + p);
        const bf16_t* qp = PJ + pjo(hq, grow) + 8 * fq;
        u32x4 raw[4];
#pragma unroll
        for (int ks = 0; ks < 4; ++ks) raw[ks] = *(const u32x4*)(qp + 32 * ks);
        if (!SBM) {
            float f[4][8]; float ss = 0.f;
#pragma unroll
            for (int ks = 0; ks < 4; ++ks) { unpack8(raw[ks], f[ks]);
#pragma unroll
                for (int e = 0; e < 8; ++e) ss += f[ks][e] * f[ks][e]; }
            ss += __shfl_xor(ss, 16); ss += __shfl_xor(ss, 32);
            const float rs = rsqrtf(ss * (1.f / 128.f) + RMS_EPS) * SM_SCALE;
#pragma unroll
            for (int ks = 0; ks < 4; ++ks) { const f32x4 g0 = *(const f32x4*)(qg + 32 * ks + 8 * fq), g1 = *(const f32x4*)(qg + 32 * ks + 8 * fq + 4);
                float o[8]; o[0] = f[ks][0] * rs * g0.x; o[1] = f[ks][1] * rs * g0.y; o[2] = f[ks][2] * rs * g0.z; o[3] = f[ks][3] * rs * g0.w;
                o[4] = f[ks][4] * rs * g1.x; o[5] = f[ks][5] * rs * g1.y; o[6] = f[ks][6] * rs * g1.z; o[7] = f[ks][7] * rs * g1.w;
                raw[ks] = pack8(o); }
        }
#pragma unroll
        for (int ks = 0; ks < 4; ++ks) qf[mb][ks] = __builtin_bit_cast(bf16x8, raw[ks]);
    }
    f32x4 o[8][MB];
#pragma unroll
    for (int c = 0; c < 8; ++c)
#pragma unroll
        for (int mb = 0; mb < MB; ++mb) o[c][mb] = (f32x4){0.f, 0.f, 0.f, 0.f};
    float R[MB], mrun[MB], lrun[MB];
#pragma unroll
    for (int mb = 0; mb < MB; ++mb) { R[mb] = 0.f; mrun[mb] = -1e30f; lrun[mb] = 0.f; }
    float kgv[8];
    if (!SBM) { const f32x4 g0 = *(const f32x4*)(kg + 8 * (tid & 15)), g1 = *(const f32x4*)(kg + 8 * (tid & 15) + 4);
        kgv[0] = g0.x; kgv[1] = g0.y; kgv[2] = g0.z; kgv[3] = g0.w; kgv[4] = g1.x; kgv[5] = g1.y; kgv[6] = g1.z; kgv[7] = g1.w; }

    const int kb_first = SBM ? 4 * qt_or_n + 3 : (qt_or_n == 0 ? 2 : 0);
    const int nkb = SBM ? kb_first + 1 : 4 - kb_first;
    LAS float* flag = (LAS float*)(lds + A_FLAG);
    if (SBM && lane == 0) flag[w] = 0.f;
    u32x4 kreg[2], vreg[2];
#define ATT_LOAD(itx) do { const int kb_ = SBM ? kb_first - (itx) : kb_first + (itx); const int kbase_ = SBM ? 64 * kb_ : 128 * (qt_or_n - 1) + 64 * kb_; \
        _Pragma("unroll") for (int i = 0; i < 2; ++i) { const int id = tid + 512 * i, rr = id >> 4, ch = id & 15; const int ki = kbase_ + rr; \
            const size_t grow = rowbase + (SBM ? (size_t)ki : (size_t)ki * r + p); \
            kreg[i] = *(const u32x4*)(PJ + pjo(hk, grow) + 8 * ch); vreg[i] = *(const u32x4*)(PJ + pjo(hv, grow) + 8 * ch); } } while (0)
    ATT_LOAD(0);
    for (int it = 0; it < nkb; ++it) {
        const int kb = SBM ? kb_first - it : kb_first + it;
        const int kbase = SBM ? 64 * kb : 128 * (qt_or_n - 1) + 64 * kb;
        __syncthreads();
        if (SBM) {
            const f32x4 f0 = *(LAS f32x4*)flag, f1 = *(LAS f32x4*)(flag + 4);
            const float mn = fminf(fminf(fminf(f0.x, f0.y), fminf(f0.z, f0.w)), fminf(fminf(f1.x, f1.y), fminf(f1.z, f1.w)));
            if (mn >= SB_STOP) break;
        }
#pragma unroll
        for (int i = 0; i < 2; ++i) {
            const int id = tid + 512 * i, rr = id >> 4, ch = id & 15;
            u32x4 kv = kreg[i];
            if (!SBM) {
                float f[8]; unpack8(kv, f); float ss = 0.f;
#pragma unroll
                for (int e = 0; e < 8; ++e) ss += f[e] * f[e];
                ss += __shfl_xor(ss, 1); ss += __shfl_xor(ss, 2); ss += __shfl_xor(ss, 4); ss += __shfl_xor(ss, 8);
                const float rs = rsqrtf(ss * (1.f / 128.f) + RMS_EPS);
#pragma unroll
                for (int e = 0; e < 8; ++e) f[e] = f[e] * rs * kgv[e];
                kv = pack8(f);
            }
            *(LAS u32x4*)(lds + A_KOFF + rr * KVS + ch * 16) = kv;
            *(LAS u32x4*)(lds + A_VOFF + rr * KVS + ch * 16) = vreg[i];
        }
        if (it + 1 < nkb) ATT_LOAD(it + 1);
        __syncthreads();
        bool active;
        if (SBM) active = (kbase < q0 + 31);
        else { const int lo = q0 - 128, hi = q0 + 15; active = (kbase + 63 >= lo) && (kbase <= hi); }
        if (active) {
            f32x4 s[4][MB];
#pragma unroll
            for (int n = 0; n < 4; ++n)
#pragma unroll
                for (int mb = 0; mb < MB; ++mb) s[n][mb] = (f32x4){0.f, 0.f, 0.f, 0.f};
#pragma unroll
            for (int n = 0; n < 4; ++n)
#pragma unroll
                for (int ks = 0; ks < 4; ++ks) { const bf16x8 kf = frag_row(lds + A_KOFF, KVS, 16 * n, 32 * ks, lane);
#pragma unroll
                    for (int mb = 0; mb < MB; ++mb) s[n][mb] = mma(kf, qf[mb][ks], s[n][mb]); }
            bf16x8 pf[MB][2];
#pragma unroll
            for (int mb = 0; mb < MB; ++mb) {
                const int qi = q0 + 16 * mb + fr;
                if (SBM) {
#pragma unroll
                    for (int n = 3; n >= 0; --n) {
                        float z[4], sp[4]; bool va[4];
#pragma unroll
                        for (int j = 0; j < 4; ++j) { const int key = kbase + 16 * n + 4 * fq + j; va[j] = key < qi; z[j] = s[n][mb][j] * SM_SCALE; sp[j] = va[j] ? softplus_f(z[j]) : 0.f; }
                        const float e2 = sp[3], e1 = e2 + sp[2], e0 = e1 + sp[1], tot = e0 + sp[0];
                        const float partner = __shfl_xor(tot, 16); const float a2 = tot + partner; const float b2 = __shfl_xor(a2, 32);
                        const float higher = ((fq & 1) == 0 ? partner : 0.f) + ((fq & 2) == 0 ? b2 : 0.f);
                        const float base = R[mb] + higher;
                        const float tl[4] = {base + e0, base + e1, base + e2, base};
#pragma unroll
                        for (int j = 0; j < 4; ++j) s[n][mb][j] = va[j] ? __expf(z[j] - sp[j] - tl[j]) : 0.f;
                        R[mb] += a2 + b2;
                    }
                } else {
                    float bm = -1e30f; bool va[4][4];
#pragma unroll
                    for (int n = 0; n < 4; ++n)
#pragma unroll
                        for (int j = 0; j < 4; ++j) { const int dist = qi - (kbase + 16 * n + 4 * fq + j); va[n][j] = (dist >= 0) && (dist <= 128); bm = fmaxf(bm, va[n][j] ? s[n][mb][j] : -1e30f); }
                    bm = fmaxf(bm, __shfl_xor(bm, 16)); bm = fmaxf(bm, __shfl_xor(bm, 32));
                    const float mnew = fmaxf(mrun[mb], bm), alpha = __expf(mrun[mb] - mnew);
                    float ps = 0.f;
#pragma unroll
                    for (int n = 0; n < 4; ++n)
#pragma unroll
                        for (int j = 0; j < 4; ++j) { const float pv = va[n][j] ? __expf(s[n][mb][j] - mnew) : 0.f; s[n][mb][j] = pv; ps += pv; }
                    lrun[mb] = lrun[mb] * alpha + ps; mrun[mb] = mnew;
#pragma unroll
                    for (int c = 0; c < 8; ++c) o[c][mb] = o[c][mb] * alpha;
                }
                pf[mb][0] = pack_frag(s[0][mb], s[1][mb]); pf[mb][1] = pack_frag(s[2][mb], s[3][mb]);
            }
#pragma unroll
            for (int c = 0; c < 8; ++c)
#pragma unroll
                for (int s2 = 0; s2 < 2; ++s2) { const bf16x8 vf = frag_tr_alt(lds + A_VOFF, KVS, 32 * s2, 16 * c, lane);
#pragma unroll
                    for (int mb = 0; mb < MB; ++mb) o[c][mb] = mma(vf, pf[mb][s2], o[c][mb]); }
            if (SBM) { float rm = fminf(R[0], R[MB - 1]);
                rm = fminf(rm, __shfl_xor(rm, 1)); rm = fminf(rm, __shfl_xor(rm, 2)); rm = fminf(rm, __shfl_xor(rm, 4)); rm = fminf(rm, __shfl_xor(rm, 8));
                if (lane == 0) flag[w] = rm; }
        }
    }
#undef ATT_LOAD
    __syncthreads();
#pragma unroll
    for (int mb = 0; mb < MB; ++mb) {
        const int qi = q0 + 16 * mb + fr;
        const size_t grow = rowbase + (SBM ? (size_t)qi : (size_t)qi * r + p);
        if (SBM) {
            const bf16_t* gp = PJ + pjo(96 + h, grow) + 4 * fq; bf16_t* op = PJ + pjo(h, grow) + 4 * fq;
#pragma unroll
            for (int c = 0; c < 8; ++c) { const u32x2 gw = *(const u32x2*)(gp + 16 * c);
                u32x2 ow; ow.x = cvtpk(o[c][mb][0] * silu_f(bflo(gw.x)), o[c][mb][1] * silu_f(bfhi(gw.x))); ow.y = cvtpk(o[c][mb][2] * silu_f(bflo(gw.y)), o[c][mb][3] * silu_f(bfhi(gw.y)));
                *(u32x2*)(op + 16 * c) = ow; }
        } else {
            float l = lrun[mb]; l += __shfl_xor(l, 16); l += __shfl_xor(l, 32);
            const float inv = 1.0f / l;
            bf16_t* op = OG + ((size_t)(g * 16 + h) * MH + grow) * 128 + 4 * fq;
#pragma unroll
            for (int c = 0; c < 8; ++c) { u32x2 ow; ow.x = cvtpk(o[c][mb][0] * inv, o[c][mb][1] * inv); ow.y = cvtpk(o[c][mb][2] * inv, o[c][mb][3] * inv); *(u32x2*)(op + 16 * c) = ow; }
            if (fq == 0) LSE[(size_t)(g * 16 + h) * MH + grow] = mrun[mb] + __logf(l);
        }
    }
}

__device__ __forceinline__ void attn_phase(LAS unsigned char* lds, bf16_t* PJ, const float* qg, const float* kg, bf16_t* OG, float* LSE) {
    const int wg = blockIdx.x;
    for (int j = 0; j < 2; ++j) {
        for (int pair = wg; pair < 256; pair += gridDim.x) {
            const int bl = pair >> 7, h = (pair >> 3) & 15, qh = pair & 7, qt = j == 0 ? 15 - qh : qh;
            attn_item<true>(lds, PJ, bl, h, qt, 1, 0, 0, qg, kg, OG, LSE);
        }
    }
    for (int id = wg; id < 2 * 16 * 96; id += gridDim.x) {
        const int bh = id / 96, rem = id % 96, bl = bh >> 4, h = bh & 15;
        int g, r, p, n;
        if (rem < 32) { g = 0; r = 1; p = 0; n = rem; }
        else if (rem < 64) { g = 1; r = 4; p = (rem - 32) >> 3; n = (rem - 32) & 7; }
        else { g = 2; r = 16; p = (rem - 64) >> 1; n = (rem - 64) & 1; }
        attn_item<false>(lds, PJ, bl, h, n, r, p, g, qg, kg, OG, LSE);
    }
}
__device__ __forceinline__ void combine_phase(bf16_t* PJ, const bf16_t* OG, const float* LSE) {
    const size_t total = (size_t)16 * MH * 16, stride = (size_t)gridDim.x * 512;
    for (size_t id = (size_t)blockIdx.x * 512 + opaque_tid(); id < total; id += stride) {
        const int ch = (int)(id & 15); const size_t hr = id >> 4; const int h = (int)(hr / MH); const size_t row = hr % MH;
        const float l0 = LSE[hr], l1 = LSE[(size_t)16 * MH + hr], l2 = LSE[(size_t)32 * MH + hr];
        const float mx = fmaxf(l0, fmaxf(l1, l2)); float w0 = __expf(l0 - mx), w1 = __expf(l1 - mx), w2 = __expf(l2 - mx);
        const float inv = 1.0f / (w0 + w1 + w2); w0 *= inv; w1 *= inv; w2 *= inv;
        float a[8], b[8], c[8], gt[8], o[8];
        unpack8(*(const u32x4*)(OG + hr * 128 + 8 * ch), a);
        unpack8(*(const u32x4*)(OG + ((size_t)16 * MH + hr) * 128 + 8 * ch), b);
        unpack8(*(const u32x4*)(OG + ((size_t)32 * MH + hr) * 128 + 8 * ch), c);
        unpack8(*(const u32x4*)(PJ + pjo(112 + h, row) + 8 * ch), gt);
#pragma unroll
        for (int e = 0; e < 8; ++e) o[e] = (w0 * a[e] + w1 * b[e] + w2 * c[e]) * silu_f(gt[e]);
        *(u32x4*)(PJ + pjo(16 + h, row) + 8 * ch) = pack8(o);
    }
}

constexpr int G_CUM = 0, G_QT = 32768, G_KT = G_QT + 64 * KVS, G_VT = G_KT + 64 * KVS, G_SBT = G_VT + 64 * KVS, G_PS = G_SBT + 128 * KVS, G_CM = G_PS + 2048, G_END = G_CM + 1024;
static_assert(G_END <= 131072, "hgrn lds");
template <bool STATE_ONLY>
__device__ __forceinline__ void hgrn_seg(LAS unsigned char* lds, const bf16_t* PJ, bf16_t* O1, const float* lbl, float* LST, float* DT, int bl, int h, int seg) {
    const int tid = opaque_tid(), lane = tid & 63, w = __builtin_amdgcn_readfirstlane(tid >> 6), fr = lane & 15, fq = lane >> 4;
    LAS float* CUM = (LAS float*)(lds + G_CUM); LAS float* PS = (LAS float*)(lds + G_PS); LAS float* CM = (LAS float*)(lds + G_CM);
    const int ch = tid & 15, c0 = 8 * ch;
    float lbv[8], oml[8];
#pragma unroll
    for (int e = 0; e < 8; ++e) { const float d = lbl[DI + h * 128 + c0 + e] - lbl[h * 128 + c0 + e]; lbv[e] = 1.0f / (1.0f + __expf(-d)); oml[e] = 1.0f - lbv[e]; }
    f32x4 S[8];
#pragma unroll
    for (int v2 = 0; v2 < 8; ++v2) S[v2] = (f32x4){0.f, 0.f, 0.f, 0.f};
    const size_t rowbase = (size_t)bl * SEQ + (size_t)seg * 1024;
    const int bh = bl * 32 + h;
    f32x4 dsum = (f32x4){0.f, 0.f, 0.f, 0.f};
    if (!STATE_ONLY) {
        for (int i = seg - 1; i >= 0; --i) {
            const float* L = LST + (size_t)(bh * 4 + i) * 16384 + (size_t)(16 * w + 4 * fq) * 128 + fr;
            const f32x4 e = (f32x4){__expf(dsum[0]), __expf(dsum[1]), __expf(dsum[2]), __expf(dsum[3])};
#pragma unroll
            for (int v2 = 0; v2 < 8; ++v2)
#pragma unroll
                for (int j = 0; j < 4; ++j) S[v2][j] += e[j] * L[j * 128 + 16 * v2];
            dsum += *(const f32x4*)(DT + (size_t)(bh * 4 + i) * 128 + 16 * w + 4 * fq);
        }
    }
    const int tb = w >> 1, vh = w & 1;
    u32x4 qn[2], fn[2], vn[2];
#define HG_LOAD(ckx) do { const size_t rr_ = rowbase + (size_t)(ckx) * 64; \
        _Pragma("unroll") for (int i = 0; i < 2; ++i) { const size_t ro_ = rr_ + (tid >> 4) + 32 * i; if (!STATE_ONLY) qn[i] = *(const u32x4*)(PJ + pjo(h, ro_) + c0); \
            fn[i] = *(const u32x4*)(PJ + pjo(32 + h, ro_) + c0); vn[i] = *(const u32x4*)(PJ + pjo(64 + h, ro_) + c0); } } while (0)
    HG_LOAD(0);
    for (int ck = 0; ck < 16; ++ck) {
        const size_t r0 = rowbase + (size_t)ck * 64;
        u32x4 qraw[2], vraw[2]; float kk[2][8];
#pragma unroll
        for (int i = 0; i < 2; ++i) {
            const int t = (tid >> 4) + 32 * i;
            if (!STATE_ONLY) qraw[i] = qn[i];
            vraw[i] = vn[i];
            float fp[8]; unpack8(fn[i], fp);
            float lf[8];
#pragma unroll
            for (int e = 0; e < 8; ++e) { const float sg = 1.0f / (1.0f + __expf(-fp[e])); const float f = lbv[e] + oml[e] * sg; lf[e] = __logf(f); kk[i][e] = oml[e] * (1.0f - sg); }
            *(LAS f32x4*)(CUM + t * 128 + c0) = (f32x4){lf[0], lf[1], lf[2], lf[3]};
            *(LAS f32x4*)(CUM + t * 128 + c0 + 4) = (f32x4){lf[4], lf[5], lf[6], lf[7]};
        }
        if (ck + 1 < 16) HG_LOAD(ck + 1);
        __syncthreads();
        { const int c = tid & 127, qr = tid >> 7; float run[16];
#pragma unroll
            for (int i = 0; i < 16; ++i) run[i] = CUM[(16 * qr + i) * 128 + c];
#pragma unroll
            for (int i = 1; i < 16; ++i) run[i] += run[i - 1];
            PS[qr * 128 + c] = run[15];
            __syncthreads();
            float off = 0.f;
#pragma unroll
            for (int q2 = 0; q2 < 3; ++q2) { const float pv = PS[q2 * 128 + c]; off += (q2 < qr) ? pv : 0.f; }
#pragma unroll
            for (int i = 0; i < 16; ++i) CUM[(16 * qr + i) * 128 + c] = run[i] + off;
            if (qr == 1) CM[c] = run[15] + off;
            if (qr == 3) CM[128 + c] = run[15] + off; }
        __syncthreads();
        { const f32x4 m0 = *(LAS f32x4*)(CM + c0), m1 = *(LAS f32x4*)(CM + c0 + 4);
            const float cm[8] = {m0.x, m0.y, m0.z, m0.w, m1.x, m1.y, m1.z, m1.w};
#pragma unroll
            for (int i = 0; i < 2; ++i) {
                const int t = (tid >> 4) + 32 * i;
                const f32x4 u0 = *(LAS f32x4*)(CUM + t * 128 + c0), u1 = *(LAS f32x4*)(CUM + t * 128 + c0 + 4);
                const float cu[8] = {u0.x, u0.y, u0.z, u0.w, u1.x, u1.y, u1.z, u1.w};
                float kt[8];
                if (!STATE_ONLY) { float q[8], qt[8]; unpack8(qraw[i], q);
#pragma unroll
                    for (int e = 0; e < 8; ++e) { const float d = cu[e] - cm[e]; qt[e] = q[e] * __expf(d); kt[e] = kk[i][e] * __expf(-d); }
                    *(LAS u32x4*)(lds + G_QT + t * KVS + ch * 16) = pack8(qt);
                } else {
#pragma unroll
                    for (int e = 0; e < 8; ++e) kt[e] = kk[i][e] * __expf(cm[e] - cu[e]);
                }
                *(LAS u32x4*)(lds + G_KT + t * KVS + ch * 16) = pack8(kt);
                *(LAS u32x4*)(lds + G_VT + t * KVS + ch * 16) = vraw[i];
            }
            if (!STATE_ONLY) {
                const f32x4 cs = *(LAS f32x4*)(CM + 16 * w + 4 * fq);
                const f32x4 es = (f32x4){__expf(cs.x), __expf(cs.y), __expf(cs.z), __expf(cs.w)};
#pragma unroll
                for (int v2 = 0; v2 < 8; ++v2) { u32x2 sw; sw.x = cvtpk(S[v2][0] * es.x, S[v2][1] * es.y); sw.y = cvtpk(S[v2][2] * es.z, S[v2][3] * es.w);
                    *(LAS u32x2*)(lds + G_SBT + (fr + 16 * v2) * KVS + (16 * w + 4 * fq) * 2) = sw; }
            }
        }
        __syncthreads();
        {
            if (!STATE_ONLY) {
                bf16x8 qtf[4];
#pragma unroll
                for (int ks = 0; ks < 4; ++ks) qtf[ks] = frag_row(lds + G_QT, KVS, 16 * tb, 32 * ks, lane);
                f32x4 out[4];
#pragma unroll
                for (int vbi = 0; vbi < 4; ++vbi) { out[vbi] = (f32x4){0.f, 0.f, 0.f, 0.f};
#pragma unroll
                    for (int ks = 0; ks < 4; ++ks) out[vbi] = mma(frag_row(lds + G_SBT, KVS, 16 * (4 * vh + vbi), 32 * ks, lane), qtf[ks], out[vbi]); }
                f32x4 at[4];
#pragma unroll
                for (int sb = 0; sb < 4; ++sb) {
                    at[sb] = (f32x4){0.f, 0.f, 0.f, 0.f};
                    if (sb <= tb) {
#pragma unroll
                        for (int ks = 0; ks < 4; ++ks) at[sb] = mma(frag_row(lds + G_KT, KVS, 16 * sb, 32 * ks, lane), qtf[ks], at[sb]);
                        if (sb == tb) {
#pragma unroll
                            for (int j = 0; j < 4; ++j) if (4 * fq + j > fr) at[sb][j] = 0.f;
                        }
                    }
                }
#pragma unroll
                for (int s2 = 0; s2 < 2; ++s2) if (2 * s2 <= tb) { const bf16x8 pf = pack_frag(at[2 * s2], at[2 * s2 + 1]);
#pragma unroll
                    for (int vbi = 0; vbi < 4; ++vbi) out[vbi] = mma(frag_tr_alt(lds + G_VT, KVS, 32 * s2, 16 * (4 * vh + vbi), lane), pf, out[vbi]); }
#pragma unroll
                for (int vbi = 0; vbi < 4; ++vbi) { u32x2 ow; ow.x = cvtpk(out[vbi][0], out[vbi][1]); ow.y = cvtpk(out[vbi][2], out[vbi][3]);
                    *(u32x2*)(O1 + ((size_t)h * MH + r0 + 16 * tb + fr) * 128 + 16 * (4 * vh + vbi) + 4 * fq) = ow; }
            }
            const f32x4 cl = *(LAS f32x4*)(CM + 128 + 16 * w + 4 * fq), cmm = *(LAS f32x4*)(CM + 16 * w + 4 * fq);
            const f32x4 e1 = (f32x4){__expf(cl[0]), __expf(cl[1]), __expf(cl[2]), __expf(cl[3])};
            const f32x4 e2 = (f32x4){__expf(cl[0] - cmm[0]), __expf(cl[1] - cmm[1]), __expf(cl[2] - cmm[2]), __expf(cl[3] - cmm[3])};
            if (STATE_ONLY) dsum += cl;
            const bf16x8 kf0 = frag_tr(lds + G_KT, KVS, 0, 16 * w, lane), kf1 = frag_tr(lds + G_KT, KVS, 32, 16 * w, lane);
#pragma unroll
            for (int v2 = 0; v2 < 8; ++v2) {
                f32x4 U = (f32x4){0.f, 0.f, 0.f, 0.f};
                U = mma(kf0, frag_tr(lds + G_VT, KVS, 0, 16 * v2, lane), U);
                U = mma(kf1, frag_tr(lds + G_VT, KVS, 32, 16 * v2, lane), U);
                S[v2] = e1 * S[v2] + e2 * U;
            }
        }
    }
#undef HG_LOAD
    if (STATE_ONLY) {
        float* L = LST + (size_t)(bh * 4 + seg) * 16384 + (size_t)(16 * w + 4 * fq) * 128 + fr;
#pragma unroll
        for (int v2 = 0; v2 < 8; ++v2)
#pragma unroll
            for (int j = 0; j < 4; ++j) L[j * 128 + 16 * v2] = S[v2][j];
        if (fr == 0) *(f32x4*)(DT + (size_t)(bh * 4 + seg) * 128 + 16 * w + 4 * fq) = dsum;
    }
    __syncthreads();
}
__device__ __forceinline__ void hgrn_post(bf16_t* PJ, const bf16_t* O1, const float* og) {
    const size_t total = (size_t)32 * MH * 16, stride = (size_t)gridDim.x * 512;
    const int tid = opaque_tid(); const int ch = tid & 15;
    const f32x4 g0 = *(const f32x4*)(og + 8 * ch), g1 = *(const f32x4*)(og + 8 * ch + 4);
    const float gg[8] = {g0.x, g0.y, g0.z, g0.w, g1.x, g1.y, g1.z, g1.w};
    for (size_t id = (size_t)blockIdx.x * 512 + tid; id < total; id += stride) {
        const size_t hr = id >> 4; const int h = (int)(hr / MH); const size_t row = hr % MH;
        float o[8], gt[8]; unpack8(*(const u32x4*)(O1 + hr * 128 + 8 * ch), o); unpack8(*(const u32x4*)(PJ + pjo(96 + h, row) + 8 * ch), gt);
        float ss = 0.f;
#pragma unroll
        for (int e = 0; e < 8; ++e) ss += o[e] * o[e];
        ss += __shfl_xor(ss, 1); ss += __shfl_xor(ss, 2); ss += __shfl_xor(ss, 4); ss += __shfl_xor(ss, 8);
        const float rs = rsqrtf(ss * (1.f / 128.f) + RMS_EPS);
#pragma unroll
        for (int e = 0; e < 8; ++e) o[e] = o[e] * rs * gg[e] * silu_f(gt[e]);
        *(u32x4*)(PJ + pjo(h, row) + 8 * ch) = pack8(o);
    }
}


#define XB_TMO      128
#define XB_XCNT(j)  (256  + 64 * (j))
#define XB_XSUB(j)  (1280 + 64 * (j))
#define XB_XGEN(j)  (2304 + 64 * (j))
#define XB_TOP      3328
#define XB_TOPGEN   3392
#define XCD_BAR_WORDS 3456
#define XB_SPIN_CAP (1u << 20)
__device__ __forceinline__ unsigned xb_ld(unsigned* p)              { return __hip_atomic_load(p, __ATOMIC_RELAXED, __HIP_MEMORY_SCOPE_AGENT); }
__device__ __forceinline__ unsigned xb_add(unsigned* p, unsigned v) { return __hip_atomic_fetch_add(p, v, __ATOMIC_RELAXED, __HIP_MEMORY_SCOPE_AGENT); }
__device__ __forceinline__ unsigned xb_xcc_id() { return (unsigned)__builtin_amdgcn_s_getreg((3 << 11) | 20) & 0xFu; }
#define XB_SPIN(cond, bar) do { unsigned _sp = 0; while (cond) { __builtin_amdgcn_s_sleep(1); \
    if ((++_sp & 255u) == 0u) { if (xb_ld(&(bar)[XB_TMO])) break; if (_sp > XB_SPIN_CAP) { atomicAdd(&(bar)[XB_TMO], 1u); break; } } } } while (0)
struct XcdBarrier { unsigned* bar; unsigned x; volatile LAS unsigned* st; };
__device__ __forceinline__ XcdBarrier xcd_barrier_post(unsigned* bar, volatile LAS unsigned* st) {
    XcdBarrier b; b.bar = bar; b.x = xb_xcc_id(); b.st = st;
    if (threadIdx.x == 0) (void)xb_add(&bar[XB_XCNT(b.x)], 1u);
    return b;
}
__device__ __forceinline__ void xcd_barrier_complete(unsigned* bar, unsigned x, unsigned& nloc, unsigned& nx) {
    const unsigned G = gridDim.x * gridDim.y * gridDim.z;
    unsigned sum, cnt, mine, sp = 0u;
    for (;;) {
        sum = 0u; cnt = 0u; mine = 0u;
#pragma unroll
        for (unsigned j = 0; j < 16; ++j) { const unsigned c = xb_ld(&bar[XB_XCNT(j)]); sum += c; cnt += (c > 0u) ? 1u : 0u; mine = (j == x) ? c : mine; }
        if (sum == G) break;
        __builtin_amdgcn_s_sleep(1);
        if ((++sp & 255u) == 0u) { if (xb_ld(&bar[XB_TMO])) break; if (sp > XB_SPIN_CAP) { atomicAdd(&bar[XB_TMO], 1u); break; } }
    }
    nloc = mine > 0u ? mine : 1u; nx = cnt > 0u ? cnt : 1u;
}
__device__ __forceinline__ void xcd_barrier(const XcdBarrier& b) {
    asm volatile("s_waitcnt vmcnt(0)" ::: "memory");
    __syncthreads();
    if (threadIdx.x == 0) {
        unsigned* bar = b.bar;
        __builtin_amdgcn_s_waitcnt(0);
        unsigned nloc = b.st[0], nx = b.st[1];
        if (nloc == 0u) { xcd_barrier_complete(bar, b.x, nloc, nx); b.st[0] = nloc; b.st[1] = nx; }
        const unsigned old = xb_add(&bar[XB_XSUB(b.x)], 1u);
        const unsigned gen = old / nloc;
        if (old + 1u == (gen + 1u) * nloc) {
            __builtin_amdgcn_fence(__ATOMIC_RELEASE, "agent");
            asm volatile("s_waitcnt vmcnt(0)" ::: "memory");
            const unsigned og = xb_add(&bar[XB_TOP], 1u);
            const unsigned tg = og / nx;
            if (og + 1u == (tg + 1u) * nx) xb_add(&bar[XB_TOPGEN], 1u);
            else XB_SPIN(xb_ld(&bar[XB_TOPGEN]) == tg, bar);
            __builtin_amdgcn_fence(__ATOMIC_ACQUIRE, "agent");
            xb_add(&bar[XB_XGEN(b.x)], 1u);
            asm volatile("s_waitcnt vmcnt(0)" ::: "memory");
        } else {
            XB_SPIN(xb_ld(&bar[XB_XGEN(b.x)]) == gen, bar);
            __builtin_amdgcn_fence(__ATOMIC_ACQUIRE, "agent");
            asm volatile("s_waitcnt vmcnt(0)" ::: "memory");
        }
    }
    __syncthreads();
}

struct Args { const float* in[11]; float* out; unsigned char* ws; unsigned long long pad; };

__global__ void __launch_bounds__(512, 2) fwd(Args a) {
    extern __shared__ __attribute__((aligned(16))) unsigned char lds_raw[];
    LAS unsigned char* lds = (LAS unsigned char*)lds_raw;
    cg::grid_group grid = cg::this_grid();
    const float* x = a.in[0]; const float* norm_even = a.in[1]; const float* w_in_even = a.in[2]; const float* qg = a.in[3]; const float* kg = a.in[4];
    const float* w_out_even = a.in[5]; const float* norm_odd = a.in[6]; const float* w_in_odd = a.in[7]; const float* lbl = a.in[8]; const float* og = a.in[9]; const float* w_out_odd = a.in[10];
    bf16_t* WinT = (bf16_t*)(a.ws + WS_WIN); bf16_t* WoT = (bf16_t*)(a.ws + WS_WO); bf16_t* XN = (bf16_t*)(a.ws + WS_XN); bf16_t* PJ = (bf16_t*)(a.ws + WS_PJ);
    bf16_t* OG = (bf16_t*)(a.ws + WS_OG); float* LSE = (float*)(a.ws + WS_LSE);
    float* LST = (float*)(a.ws + WS_OG + 64 * MiB); float* DTOT = (float*)(a.ws + WS_OG + 80 * MiB);
    float* out = a.out;
    volatile LAS unsigned* bst = (volatile LAS unsigned*)(lds + LDS_BYTES - 64);
    if (threadIdx.x < 2) bst[threadIdx.x] = 0u;
    __syncthreads();
    const XcdBarrier xbar = xcd_barrier_post((unsigned*)a.ws, bst);
#define GSYNC() xcd_barrier(xbar)

#ifdef PROBE_SEL
    unsigned long long tprev = __builtin_amdgcn_s_memrealtime(), tacc = 0ull;
#define STAMP(kind) do { const unsigned long long now_ = __builtin_amdgcn_s_memrealtime(); if ((PROBE_SEL >> ((kind) + 8 * layer)) & 1) tacc += now_ - tprev; tprev = now_; } while (0)
#else
#define STAMP(kind) do { } while (0)
#endif
    for (int layer = 0; layer < 2; ++layer) {
        prologue(lds, layer == 0 ? x : out, layer == 0 ? norm_even : norm_odd, layer == 0 ? w_in_even : w_in_odd, layer == 0 ? w_out_even : w_out_odd, WinT, WoT, XN);
        if (layer == 0) grid.sync(); else GSYNC();
        STAMP(0);
        for (int half = 0; half < 2; ++half) {
            { pg8::Gemm g{XN + (size_t)half * MH * DM, WinT, MH, NC, DM, DM, 5, 0}; pg8::StaticOrder S; S.init(MH, NC, gridDim.x, blockIdx.x);
              pg8::EpiBf16 E{PJ, NC}; pg8::gemm_phase<pg8::EpiBf16>(lds, g, S, E); }
            GSYNC(); STAMP(1);
            if (layer == 0) {
                attn_phase(lds, PJ, qg, kg, OG, LSE);
                GSYNC(); STAMP(2);
                combine_phase(PJ, OG, LSE);
            } else {
                for (int it = blockIdx.x; it < 256; it += gridDim.x) { if ((it & 3) < 3) hgrn_seg<true>(lds, PJ, OG, lbl, LST, DTOT, it >> 7, (it >> 2) & 31, it & 3); }
                GSYNC();
                for (int it = blockIdx.x; it < 256; it += gridDim.x) hgrn_seg<false>(lds, PJ, OG, lbl, LST, DTOT, it >> 7, (it >> 2) & 31, it & 3);
                GSYNC(); STAMP(2);
                hgrn_post(PJ, OG, og);
            }
            GSYNC(); STAMP(3);
            { pg8::Gemm g{PJ, WoT, MH, DM, DI, 128, 1, (size_t)MH * 256}; pg8::StaticOrder S; S.init(MH, DM, gridDim.x, blockIdx.x);
              const float* res = (layer == 0 ? x : out) + (size_t)half * MH * DM;
              pg8::EpiRes E{res, out + (size_t)half * MH * DM, DM}; pg8::gemm_phase<pg8::EpiRes>(lds, g, S, E); }
            if (layer == 0 || half == 0) GSYNC();
            STAMP(4);
        }
    }
#ifdef PROBE_SEL
    if (blockIdx.x == 0) { const int K = (int)(tacc / 100ull); for (int i = threadIdx.x; i < K; i += 512) out[i] += 0.125f; }
#endif
}

extern "C" void kernel_launch(void* const* d_in, const int* in_sizes, int n_in, void* d_out, int out_size, void* d_ws, size_t ws_size, hipStream_t stream) {
    static int grid = 0;
    if (grid == 0) {
        if (n_in != 11 || out_size != MTOK * DM || ws_size < WS_END) { fprintf(stderr, "kernel_launch: unexpected shapes (n_in %d out %d ws %zu)\n", n_in, out_size, ws_size); grid = -1; return; }
        int dev = 0, cus = 0, per_cu = 0;
        (void)hipGetDevice(&dev);
        (void)hipDeviceGetAttribute(&cus, hipDeviceAttributeMultiprocessorCount, dev);
        (void)hipFuncSetAttribute((const void*)fwd, hipFuncAttributeMaxDynamicSharedMemorySize, LDS_BYTES);
        (void)hipOccupancyMaxActiveBlocksPerMultiprocessor(&per_cu, (const void*)fwd, 512, LDS_BYTES);
        (void)hipGetLastError();
        grid = cus > 0 ? cus : 256;
    }
    if (grid < 0) return;
    (void)hipMemsetAsync(d_ws, 0, 16384, stream);
    Args a{};
    for (int i = 0; i < 11; ++i) a.in[i] = (const float*)d_in[i];
    a.out = (float*)d_out; a.ws = (unsigned char*)d_ws;
    void* args[] = {&a};
    hipError_t e = hipLaunchCooperativeKernel((const void*)fwd, dim3(grid), dim3(512), args, LDS_BYTES, stream);
    if (e != hipSuccess) fprintf(stderr, "cooperative launch failed: %s\n", hipGetErrorString(e));
}
```

```cpp
#include <hip/hip_runtime.h>
#include <hip/hip_cooperative_groups.h>
#include <cstdio>
namespace cg = cooperative_groups;

#define LAS __attribute__((address_space(3)))
typedef unsigned short bf16_t;
typedef short bf16x8 __attribute__((ext_vector_type(8)));
typedef short s16x4 __attribute__((ext_vector_type(4)));
typedef float f32x4 __attribute__((ext_vector_type(4)));
typedef float f32x2_t __attribute__((ext_vector_type(2)));
typedef __bf16 bf16x2_t __attribute__((ext_vector_type(2)));
typedef unsigned u32x4 __attribute__((ext_vector_type(4)));
typedef unsigned u32x2 __attribute__((ext_vector_type(2)));

constexpr int SEQ = 4096, DM = 2048, NC = 16384, DI = 4096, MTOK = 16384, MH = 8192;
constexpr float RMS_EPS = 1e-6f;
constexpr size_t MiB = 1u << 20;
constexpr size_t WS_WIN = 1 * MiB, WS_WO = 65 * MiB, WS_XN = 81 * MiB, WS_PJ = 145 * MiB, WS_OG = 401 * MiB, WS_LSE = 497 * MiB, WS_END = 499 * MiB;
constexpr int LDS_BYTES = 147456;

__device__ __forceinline__ unsigned cvtpk(float lo, float hi) { f32x2_t v = {lo, hi}; bf16x2_t b = __builtin_convertvector(v, bf16x2_t); return __builtin_bit_cast(unsigned, b); }
__device__ __forceinline__ float bflo(unsigned w) { return __uint_as_float(w << 16); }
__device__ __forceinline__ float bfhi(unsigned w) { return __uint_as_float(w & 0xffff0000u); }
__device__ __forceinline__ void unpack8(const u32x4 w, float* f) { f[0] = bflo(w.x); f[1] = bfhi(w.x); f[2] = bflo(w.y); f[3] = bfhi(w.y); f[4] = bflo(w.z); f[5] = bfhi(w.z); f[6] = bflo(w.w); f[7] = bfhi(w.w); }
__device__ __forceinline__ u32x4 pack8(const float* f) { u32x4 w; w.x = cvtpk(f[0], f[1]); w.y = cvtpk(f[2], f[3]); w.z = cvtpk(f[4], f[5]); w.w = cvtpk(f[6], f[7]); return w; }
__device__ __forceinline__ float silu_f(float g) { return g / (1.0f + __expf(-g)); }
__device__ __forceinline__ float softplus_f(float z) { return fmaxf(z, 0.f) + __logf(1.0f + __expf(-fabsf(z))); }

__device__ __forceinline__ int opaque_tid() { int t = threadIdx.x; asm volatile("" : "+v"(t)); return t; }

__device__ __forceinline__ size_t pjo(int hg, size_t row) { return ((size_t)hg * MH + row) * 128; }

__device__ __forceinline__ bf16x8 frag_row(LAS const unsigned char* tile, int stride, int r0, int k0, int lane) {
    return *(LAS const bf16x8*)(tile + (r0 + (lane & 15)) * stride + (k0 + 8 * (lane >> 4)) * 2);
}
__device__ __forceinline__ s16x4 tr4(LAS const unsigned char* p) { return __builtin_bit_cast(s16x4, __builtin_amdgcn_ds_read_tr16_b64_v4i16((LAS s16x4*)p)); }
__device__ __forceinline__ bf16x8 frag_tr(LAS const unsigned char* tile, int stride, int k0, int n0, int lane) {
    const int g = lane >> 4, q = (lane & 15) >> 2, p = lane & 3;
    LAS const unsigned char* a = tile + (k0 + 8 * g + q) * stride + (n0 + 4 * p) * 2;
    const s16x4 lo = tr4(a), hi = tr4(a + 4 * stride);
    return (bf16x8){lo[0], lo[1], lo[2], lo[3], hi[0], hi[1], hi[2], hi[3]};
}
__device__ __forceinline__ bf16x8 frag_tr_alt(LAS const unsigned char* tile, int stride, int k0, int n0, int lane) {
    const int g = lane >> 4, q = (lane & 15) >> 2, p = lane & 3;
    LAS const unsigned char* a = tile + (k0 + 4 * g + q) * stride + (n0 + 4 * p) * 2;
    const s16x4 lo = tr4(a), hi = tr4(a + 16 * stride);
    return (bf16x8){lo[0], lo[1], lo[2], lo[3], hi[0], hi[1], hi[2], hi[3]};
}
__device__ __forceinline__ f32x4 mma(bf16x8 a, bf16x8 b, f32x4 c) { return __builtin_amdgcn_mfma_f32_16x16x32_bf16(a, b, c, 0, 0, 0); }
__device__ __forceinline__ bf16x8 pack_frag(const f32x4 lo, const f32x4 hi) {
    u32x4 w; w.x = cvtpk(lo[0], lo[1]); w.y = cvtpk(lo[2], lo[3]); w.z = cvtpk(hi[0], hi[1]); w.w = cvtpk(hi[2], hi[3]);
    return __builtin_bit_cast(bf16x8, w);
}

namespace pg8 {
constexpr int BM = 256, BK = 64, HALF = 128, HTB = HALF * BK * 2, STAGE_BYTES = 8 * HTB, NXCD = 8, WGM = 8;
__device__ __forceinline__ int lds_byte(int r, int c) { const int st = (r >> 4) * 2 + (c >> 5), rr = r & 15, cc = c & 31, ob = rr * 64 + cc * 2; return st * 1024 + (ob ^ (((ob >> 9) & 1) << 5)); }
__device__ __forceinline__ void stage_rc(int b, int& R, int& C) { const int st = b / 1024, sb = b % 1024, swz = sb ^ (((sb >> 9) & 1) << 5); R = (st >> 1) * 16 + swz / 64; C = (st & 1) * 32 + (swz % 64) / 2; }
__device__ __forceinline__ int perm32(int rho) { const int n = rho >> 4, i = rho & 15; return 8 * (i >> 2) + 4 * n + (i & 3); }
struct Unit { int pm, pn; };
struct Gemm { const bf16_t* A; const bf16_t* Bt; int M, N, K, lda, ksh; size_t kbig; };
struct StaticOrder {
    int nM, nN, nwg, G, c;
    __device__ void init(int M, int N, int G_, int c_) { nM = M / BM; nN = N / BM; nwg = nM * nN; G = G_; c = c_; }
    __device__ bool next(int i, Unit& u) const {
        const long L = (long)i * G + c; if (L >= nwg) return false;
        int wgid = (int)L; { const int q = nwg / NXCD, r = nwg % NXCD, xcd = wgid % NXCD, off = wgid / NXCD; wgid = (xcd < r ? xcd * (q + 1) : r * (q + 1) + (xcd - r) * q) + off; }
        const int nig = WGM * nN, gid = wgid / nig, fm = gid * WGM, gsz = (nM - fm) < WGM ? (nM - fm) : WGM;
        u.pm = fm + ((wgid % nig) % gsz); u.pn = (wgid % nig) / gsz; return true;
    }
};
struct EpiBf16 {
    static constexpr bool PERM = true;
    bf16_t* O; int ldc;
    __device__ __forceinline__ void operator()(const f32x4 (&acc)[2][2][4][2], const Unit& u, int wr, int wc, int fr, int fq) const {
        const int row0 = u.pm * BM + wr * 64 + fr, d0 = wc * 32 + 8 * fq;
#pragma unroll
        for (int ai = 0; ai < 2; ++ai)
#pragma unroll
            for (int m = 0; m < 4; ++m) {
#pragma unroll
                for (int bj = 0; bj < 2; ++bj) { const f32x4 v0 = acc[ai][bj][m][0], v1 = acc[ai][bj][m][1];
                    u32x4 w; w.x = cvtpk(v0[0], v0[1]); w.y = cvtpk(v0[2], v0[3]); w.z = cvtpk(v1[0], v1[1]); w.w = cvtpk(v1[2], v1[3]);
                    *(u32x4*)(O + pjo(2 * u.pn + bj, (size_t)(row0 + ai * HALF + m * 16)) + d0) = w; } }
    }
};
struct EpiRes {
    static constexpr bool PERM = false;
    const float* R; float* C; int ldc;
    __device__ __forceinline__ void operator()(const f32x4 (&acc)[2][2][4][2], const Unit& u, int wr, int wc, int fr, int fq) const {
        const int row0 = u.pm * BM + wr * 64 + fr, col0 = u.pn * BM + wc * 32 + 4 * fq;
#pragma unroll
        for (int ai = 0; ai < 2; ++ai)
#pragma unroll
            for (int m = 0; m < 4; ++m) { const size_t ro = (size_t)(row0 + ai * HALF + m * 16) * ldc + col0;
#pragma unroll
                for (int bj = 0; bj < 2; ++bj)
#pragma unroll
                    for (int n = 0; n < 2; ++n) { const f32x4 r = *(const f32x4*)(R + ro + bj * HALF + n * 16); *(f32x4*)(C + ro + bj * HALF + n * 16) = acc[ai][bj][m][n] + r; } }
    }
};

template <class Epi>
__device__ __forceinline__ void gemm_phase(LAS unsigned char* lds, const Gemm g, const StaticOrder& S, const Epi& E) {
    const int tid = opaque_tid(), wid = __builtin_amdgcn_readfirstlane(tid >> 6), lane = tid & 63, wr = wid >> 2, wc = wid & 3, fr = lane & 15, fq = lane >> 4;
    const int K = g.K, nt = K / BK, lda = g.lda, ksh = g.ksh, kmask = (1 << g.ksh) - 1;
    unsigned voffA[2], voffB[2];
#pragma unroll
    for (int i = 0; i < 2; ++i) { int R, C; stage_rc(tid * 16 + i * 8192, R, C); const int Rb = Epi::PERM ? ((R & ~31) + perm32(R & 31)) : R;
        voffA[i] = (unsigned)(R * lda + C) * 2u; voffB[i] = (unsigned)(Rb * K + C) * 2u; }
    const size_t kstep = (size_t)(BK * 2);
    const size_t hstepA = (size_t)HALF * lda * 2, hstepB = (size_t)HALF * K * 2;
    const size_t tstepA = 2 * hstepA, tstepB = 2 * hstepB;
    const unsigned ldsw = (unsigned)wid * 1024u;
    const int aoff = lds_byte(wr * 64 + fr, fq * 8), boff = lds_byte(wc * 32 + fr, fq * 8);
#define PG8_SA(b, h) (((b) * 2 + (h)) * HTB)
#define PG8_SB(b, h) ((4 + (b) * 2 + (h)) * HTB)
#define PG8_STAGE(bufoff, gbase, voff) do { _Pragma("unroll") for (int _i = 0; _i < 2; ++_i) \
        __builtin_amdgcn_global_load_lds((const unsigned*)((const char*)(gbase) + (voff)[_i]), (LAS unsigned*)(lds + (bufoff) + ldsw + _i * 8192), 16, 0, 0); } while (0)
#define PG8_LDA(dst, b, h) do { _Pragma("unroll") for (int m = 0; m < 4; ++m) _Pragma("unroll") for (int k = 0; k < 2; ++k) dst[m][k] = *(const LAS bf16x8*)(lds + PG8_SA(b, h) + aoff + m * 2048 + k * 1024); } while (0)
#define PG8_LDB(dst, b, h) do { _Pragma("unroll") for (int n = 0; n < 2; ++n) _Pragma("unroll") for (int k = 0; k < 2; ++k) dst[n][k] = *(const LAS bf16x8*)(lds + PG8_SB(b, h) + boff + n * 2048 + k * 1024); } while (0)
#define PG8_MMA(ai, bj, At, Bt) do { __builtin_amdgcn_s_setprio(1); _Pragma("unroll") for (int m = 0; m < 4; ++m) _Pragma("unroll") for (int n = 0; n < 2; ++n) _Pragma("unroll") for (int k = 0; k < 2; ++k) \
        acc[ai][bj][m][n] = __builtin_amdgcn_mfma_f32_16x16x32_bf16(Bt[n][k], At[m][k], acc[ai][bj][m][n], 0, 0, 0); __builtin_amdgcn_s_setprio(0); } while (0)
#define PG8_WAIT_V(n) asm volatile("s_waitcnt vmcnt(" #n ")" ::: "memory")
#define PG8_WAIT_L(n) asm volatile("s_waitcnt lgkmcnt(" #n ")" ::: "memory")
#define PG8_BAR __builtin_amdgcn_s_barrier()
#define PG8_SCHED __builtin_amdgcn_sched_barrier(0)
    Unit cur, nxt; int ui = 0;
    if (!S.next(0, cur)) return;
    f32x4 acc[2][2][4][2];
#pragma unroll
    for (int a = 0; a < 2; ++a)
#pragma unroll
        for (int b = 0; b < 2; ++b)
#pragma unroll
            for (int m = 0; m < 4; ++m)
#pragma unroll
                for (int n = 0; n < 2; ++n) acc[a][b][m][n] = (f32x4){0.f, 0.f, 0.f, 0.f};
    bf16x8 At[4][2], B0[2][2], B1[2][2];
    const char* cA = (const char*)g.A + (size_t)cur.pm * tstepA; const char* cB = (const char*)g.Bt + (size_t)cur.pn * tstepB;
    PG8_STAGE(PG8_SB(0, 0), cB, voffB); PG8_STAGE(PG8_SA(0, 0), cA, voffA); PG8_STAGE(PG8_SB(0, 1), cB + hstepB, voffB); PG8_STAGE(PG8_SA(0, 1), cA + hstepA, voffA);
    if (wr == 1) PG8_BAR;
    PG8_WAIT_V(4); PG8_BAR;
    PG8_STAGE(PG8_SB(1, 0), cB + kstep, voffB); PG8_STAGE(PG8_SA(1, 0), cA + kstep, voffA); PG8_STAGE(PG8_SB(1, 1), cB + hstepB + kstep, voffB);
    PG8_WAIT_V(6); PG8_BAR;
    for (;;) {
        const bool has_next = S.next(ui + 1, nxt);
        const char* nA = has_next ? (const char*)g.A + (size_t)nxt.pm * tstepA : cA; const char* nB = has_next ? (const char*)g.Bt + (size_t)nxt.pn * tstepB : cB;
        for (int t = 0; t < nt; t += 2) {
            const bool last = (t == nt - 2);
            const char* a1 = cA + ((size_t)(t >> ksh) * g.kbig + (size_t)(t & kmask) * kstep) + kstep;
            const char* a2 = last ? nA : cA + ((size_t)((t + 2) >> ksh) * g.kbig + (size_t)((t + 2) & kmask) * kstep); const char* b2 = last ? nB : cB + (size_t)(t + 2) * kstep;
            const char* a3 = a2 + kstep; const char* b3 = b2 + kstep;
            PG8_LDB(B0, 0, 0); PG8_SCHED; PG8_LDA(At, 0, 0); PG8_STAGE(PG8_SA(1, 1), a1 + hstepA, voffA);
            PG8_WAIT_L(8); PG8_BAR; PG8_WAIT_L(0); PG8_MMA(0, 0, At, B0); PG8_BAR; PG8_SCHED;
            PG8_LDB(B1, 0, 1); PG8_STAGE(PG8_SB(0, 0), b2, voffB);
            PG8_BAR; PG8_WAIT_L(0); PG8_MMA(0, 1, At, B1); PG8_BAR;
            PG8_LDA(At, 0, 1); PG8_STAGE(PG8_SA(0, 0), a2, voffA);
            PG8_BAR; PG8_WAIT_L(0); PG8_MMA(1, 0, At, B0); PG8_BAR; PG8_SCHED;
            PG8_STAGE(PG8_SB(0, 1), b2 + hstepB, voffB);
            PG8_WAIT_V(6); PG8_BAR; PG8_MMA(1, 1, At, B1); PG8_BAR;
            PG8_LDB(B0, 1, 0); PG8_SCHED; PG8_LDA(At, 1, 0); PG8_STAGE(PG8_SA(0, 1), a2 + hstepA, voffA);
            PG8_WAIT_L(8); PG8_BAR; PG8_WAIT_L(0); PG8_MMA(0, 0, At, B0); PG8_BAR; PG8_SCHED;
            PG8_LDB(B1, 1, 1); PG8_STAGE(PG8_SB(1, 0), b3, voffB);
            PG8_BAR; PG8_WAIT_L(0); PG8_MMA(0, 1, At, B1); PG8_BAR;
            PG8_LDA(At, 1, 1); PG8_STAGE(PG8_SA(1, 0), a3, voffA);
            PG8_BAR; PG8_WAIT_L(0); PG8_MMA(1, 0, At, B0); PG8_BAR; PG8_SCHED;
            PG8_STAGE(PG8_SB(1, 1), b3 + hstepB, voffB);
            PG8_WAIT_V(6); PG8_BAR; PG8_MMA(1, 1, At, B1); PG8_BAR;
        }
        E(acc, cur, wr, wc, fr, fq);
        if (!has_next) break;
#pragma unroll
        for (int a = 0; a < 2; ++a)
#pragma unroll
            for (int b = 0; b < 2; ++b)
#pragma unroll
                for (int m = 0; m < 4; ++m)
#pragma unroll
                    for (int n = 0; n < 2; ++n) acc[a][b][m][n] = (f32x4){0.f, 0.f, 0.f, 0.f};
        cur = nxt; cA = nA; cB = nB; ++ui;
    }
    PG8_WAIT_V(0);
    if (wr == 0) PG8_BAR;
    PG8_BAR;
#undef PG8_SA
#undef PG8_SB
#undef PG8_STAGE
#undef PG8_LDA
#undef PG8_LDB
#undef PG8_MMA
#undef PG8_WAIT_V
#undef PG8_WAIT_L
#undef PG8_BAR
#undef PG8_SCHED
}
}

__device__ __forceinline__ float wave_sum(float v) {
#pragma unroll
    for (int o = 1; o < 64; o <<= 1) v += __shfl_xor(v, o);
    return v;
}
__device__ __forceinline__ void transpose_item(const float* __restrict__ W, int K, int N, bf16_t* __restrict__ WT, LAS float* scr, int item, int lane) {
    const int nblk = N / 32, kb = item / nblk, nb = item % nblk, k0 = 64 * kb, n0 = 32 * nb;
#pragma unroll 8
    for (int i = 0; i < 32; ++i) { const int kk = 2 * i + (lane >> 5); scr[kk * 33 + (lane & 31)] = W[(size_t)(k0 + kk) * N + n0 + (lane & 31)]; }
    asm volatile("s_waitcnt lgkmcnt(0)" ::: "memory");
    const int c = lane & 7;
#pragma unroll
    for (int j = 0; j < 4; ++j) { const int n = (lane >> 3) + 8 * j; const LAS float* s = scr + (8 * c) * 33 + n;
        u32x4 o; o.x = cvtpk(s[0 * 33], s[1 * 33]); o.y = cvtpk(s[2 * 33], s[3 * 33]); o.z = cvtpk(s[4 * 33], s[5 * 33]); o.w = cvtpk(s[6 * 33], s[7 * 33]);
        *(u32x4*)(WT + (size_t)(n0 + n) * K + k0 + 8 * c) = o; }
    asm volatile("s_waitcnt lgkmcnt(0)" ::: "memory");
}
__device__ __forceinline__ void rms_row_to_bf16(const float* xrow, const float* g, bf16_t* orow, int lane) {
    const f32x4* xr = (const f32x4*)xrow + lane; const f32x4* gr = (const f32x4*)g + lane;
    f32x4 v[8]; float s = 0.f;
#pragma unroll
    for (int j = 0; j < 8; ++j) { v[j] = xr[64 * j]; s += (v[j].x * v[j].x + v[j].y * v[j].y) + (v[j].z * v[j].z + v[j].w * v[j].w); }
    const float rstd = rsqrtf(wave_sum(s) * (1.f / DM) + RMS_EPS);
    u32x2* o8 = (u32x2*)orow + lane;
#pragma unroll
    for (int j = 0; j < 8; ++j) { const f32x4 gg = gr[64 * j]; u32x2 w; w.x = cvtpk(v[j].x * rstd * gg.x, v[j].y * rstd * gg.y); w.y = cvtpk(v[j].z * rstd * gg.z, v[j].w * rstd * gg.w); o8[64 * j] = w; }
}
__device__ __forceinline__ void prologue(LAS unsigned char* lds, const float* x, const float* ng, const float* w_in, const float* w_out, bf16_t* WinT, bf16_t* WoT, bf16_t* XN) {
    const int tid = opaque_tid(), lane = tid & 63, wave = tid >> 6;
    LAS float* scr = (LAS float*)(lds + wave * 16384);
    const int gw = blockIdx.x * 8 + wave, NGW = gridDim.x * 8;
    constexpr int I_IN = (DM / 64) * (NC / 32), I_OUT = (DI / 64) * (DM / 32);
    for (int it = gw; it < I_IN + I_OUT; it += NGW) {
        if (it < I_IN) transpose_item(w_in, DM, NC, WinT, scr, it, lane);
        else transpose_item(w_out, DI, DM, WoT, scr, it - I_IN, lane);
    }
    for (int m = gw; m < MTOK; m += NGW) rms_row_to_bf16(x + (size_t)m * DM, ng, XN + (size_t)m * DM, lane);
}

constexpr int KVS = 272;
constexpr int A_KOFF = 0, A_VOFF = 64 * KVS, A_FLAG = 2 * 64 * KVS;
constexpr float SB_STOP = 104.0f;
constexpr float SM_SCALE = 0.08838834764831845f;

template <bool SBM>
__device__ __forceinline__ void attn_item(LAS unsigned char* lds, bf16_t* PJ, int bl, int h, int qt_or_n, int r, int p, int g,
                                          const float* qg, const float* kg, bf16_t* OG, float* LSE) {
    constexpr int MB = SBM ? 2 : 1;
    const int tid = opaque_tid(), lane = tid & 63, w = __builtin_amdgcn_readfirstlane(tid >> 6), fr = lane & 15, fq = lane >> 4;
    const int hq = SBM ? h : 48 + h, hk = SBM ? 16 + h : 64 + h, hv = SBM ? 32 + h : 80 + h;
    const size_t rowbase = (size_t)bl * SEQ;
    const int q0 = SBM ? qt_or_n * 256 + 32 * w : qt_or_n * 128 + 16 * w;
    bf16x8 qf[MB][4];
#pragma unroll
    for (int mb = 0; mb < MB; ++mb) {
        const int qi = q0 + 16 * mb + fr;
        const size_t grow = rowbase + (SBM ? (size_t)qi : (size_t)qi * r + p);
        const bf16_t* qp = PJ + pjo(hq, grow) + 8 * fq;
        u32x4 raw[4];
#pragma unroll
        for (int ks = 0; ks < 4; ++ks) raw[ks] = *(const u32x4*)(qp + 32 * ks);
        if (!SBM) {
            float f[4][8]; float ss = 0.f;
#pragma unroll
            for (int ks = 0; ks < 4; ++ks) { unpack8(raw[ks], f[ks]);
#pragma unroll
                for (int e = 0; e < 8; ++e) ss += f[ks][e] * f[ks][e]; }
            ss += __shfl_xor(ss, 16); ss += __shfl_xor(ss, 32);
            const float rs = rsqrtf(ss * (1.f / 128.f) + RMS_EPS) * SM_SCALE;
#pragma unroll
            for (int ks = 0; ks < 4; ++ks) { const f32x4 g0 = *(const f32x4*)(qg + 32 * ks + 8 * fq), g1 = *(const f32x4*)(qg + 32 * ks + 8 * fq + 4);
                float o[8]; o[0] = f[ks][0] * rs * g0.x; o[1] = f[ks][1] * rs * g0.y; o[2] = f[ks][2] * rs * g0.z; o[3] = f[ks][3] * rs * g0.w;
                o[4] = f[ks][4] * rs * g1.x; o[5] = f[ks][5] * rs * g1.y; o[6] = f[ks][6] * rs * g1.z; o[7] = f[ks][7] * rs * g1.w;
                raw[ks] = pack8(o); }
        }
#pragma unroll
        for (int ks = 0; ks < 4; ++ks) qf[mb][ks] = __builtin_bit_cast(bf16x8, raw[ks]);
    }
    f32x4 o[8][MB];
#pragma unroll
    for (int c = 0; c < 8; ++c)
#pragma unroll
        for (int mb = 0; mb < MB; ++mb) o[c][mb] = (f32x4){0.f, 0.f, 0.f, 0.f};
    float R[MB], mrun[MB], lrun[MB];
#pragma unroll
    for (int mb = 0; mb < MB; ++mb) { R[mb] = 0.f; mrun[mb] = -1e30f; lrun[mb] = 0.f; }
    float kgv[8];
    if (!SBM) { const f32x4 g0 = *(const f32x4*)(kg + 8 * (tid & 15)), g1 = *(const f32x4*)(kg + 8 * (tid & 15) + 4);
        kgv[0] = g0.x; kgv[1] = g0.y; kgv[2] = g0.z; kgv[3] = g0.w; kgv[4] = g1.x; kgv[5] = g1.y; kgv[6] = g1.z; kgv[7] = g1.w; }

    const int kb_first = SBM ? 4 * qt_or_n + 3 : (qt_or_n == 0 ? 2 : 0);
    const int nkb = SBM ? kb_first + 1 : 4 - kb_first;
    LAS float* flag = (LAS float*)(lds + A_FLAG);
    if (SBM && lane == 0) flag[w] = 0.f;
    u32x4 kreg[2], vreg[2];
#define ATT_LOAD(itx) do { const int kb_ = SBM ? kb_first - (itx) : kb_first + (itx); const int kbase_ = SBM ? 64 * kb_ : 128 * (qt_or_n - 1) + 64 * kb_; \
        _Pragma("unroll") for (int i = 0; i < 2; ++i) { const int id = tid + 512 * i, rr = id >> 4, ch = id & 15; const int ki = kbase_ + rr; \
            const size_t grow = rowbase + (SBM ? (size_t)ki : (size_t)ki * r + p); \
            kreg[i] = *(const u32x4*)(PJ + pjo(hk, grow) + 8 * ch); vreg[i] = *(const u32x4*)(PJ + pjo(hv, grow) + 8 * ch); } } while (0)
    ATT_LOAD(0);
    for (int it = 0; it < nkb; ++it) {
        const int kb = SBM ? kb_first - it : kb_first + it;
        const int kbase = SBM ? 64 * kb : 128 * (qt_or_n - 1) + 64 * kb;
        __syncthreads();
        if (SBM) {
            const f32x4 f0 = *(LAS f32x4*)flag, f1 = *(LAS f32x4*)(flag + 4);
            const float mn = fminf(fminf(fminf(f0.x, f0.y), fminf(f0.z, f0.w)), fminf(fminf(f1.x, f1.y), fminf(f1.z, f1.w)));
            if (mn >= SB_STOP) break;
        }
#pragma unroll
        for (int i = 0; i < 2; ++i) {
            const int id = tid + 512 * i, rr = id >> 4, ch = id & 15;
            u32x4 kv = kreg[i];
            if (!SBM) {
                float f[8]; unpack8(kv, f); float ss = 0.f;
#pragma unroll
                for (int e = 0; e < 8; ++e) ss += f[e] * f[e];
                ss += __shfl_xor(ss, 1); ss += __shfl_xor(ss, 2); ss += __shfl_xor(ss, 4); ss += __shfl_xor(ss, 8);
                const float rs = rsqrtf(ss * (1.f / 128.f) + RMS_EPS);
#pragma unroll
                for (int e = 0; e < 8; ++e) f[e] = f[e] * rs * kgv[e];
                kv = pack8(f);
            }
            *(LAS u32x4*)(lds + A_KOFF + rr * KVS + ch * 16) = kv;
            *(LAS u32x4*)(lds + A_VOFF + rr * KVS + ch * 16) = vreg[i];
        }
        if (it + 1 < nkb) ATT_LOAD(it + 1);
        __syncthreads();
        bool active;
        if (SBM) active = (kbase < q0 + 31);
        else { const int lo = q0 - 128, hi = q0 + 15; active = (kbase + 63 >= lo) && (kbase <= hi); }
        if (active) {
            f32x4 s[4][MB];
#pragma unroll
            for (int n = 0; n < 4; ++n)
#pragma unroll
                for (int mb = 0; mb < MB; ++mb) s[n][mb] = (f32x4){0.f, 0.f, 0.f, 0.f};
#pragma unroll
            for (int n = 0; n < 4; ++n)
#pragma unroll
                for (int ks = 0; ks < 4; ++ks) { const bf16x8 kf = frag_row(lds + A_KOFF, KVS, 16 * n, 32 * ks, lane);
#pragma unroll
                    for (int mb = 0; mb < MB; ++mb) s[n][mb] = mma(kf, qf[mb][ks], s[n][mb]); }
            bf16x8 pf[MB][2];
#pragma unroll
            for (int mb = 0; mb < MB; ++mb) {
                const int qi = q0 + 16 * mb + fr;
                if (SBM) {
#pragma unroll
                    for (int n = 3; n >= 0; --n) {
                        float z[4], sp[4]; bool va[4];
#pragma unroll
                        for (int j = 0; j < 4; ++j) { const int key = kbase + 16 * n + 4 * fq + j; va[j] = key < qi; z[j] = s[n][mb][j] * SM_SCALE; sp[j] = va[j] ? softplus_f(z[j]) : 0.f; }
                        const float e2 = sp[3], e1 = e2 + sp[2], e0 = e1 + sp[1], tot = e0 + sp[0];
                        const float partner = __shfl_xor(tot, 16); const float a2 = tot + partner; const float b2 = __shfl_xor(a2, 32);
                        const float higher = ((fq & 1) == 0 ? partner : 0.f) + ((fq & 2) == 0 ? b2 : 0.f);
                        const float base = R[mb] + higher;
                        const float tl[4] = {base + e0, base + e1, base + e2, base};
#pragma unroll
                        for (int j = 0; j < 4; ++j) s[n][mb][j] = va[j] ? __expf(z[j] - sp[j] - tl[j]) : 0.f;
                        R[mb] += a2 + b2;
                    }
                } else {
                    float bm = -1e30f; bool va[4][4];
#pragma unroll
                    for (int n = 0; n < 4; ++n)
#pragma unroll
                        for (int j = 0; j < 4; ++j) { const int dist = qi - (kbase + 16 * n + 4 * fq + j); va[n][j] = (dist >= 0) && (dist <= 128); bm = fmaxf(bm, va[n][j] ? s[n][mb][j] : -1e30f); }
                    bm = fmaxf(bm, __shfl_xor(bm, 16)); bm = fmaxf(bm, __shfl_xor(bm, 32));
                    const float mnew = fmaxf(mrun[mb], bm), alpha = __expf(mrun[mb] - mnew);
                    float ps = 0.f;
#pragma unroll
                    for (int n = 0; n < 4; ++n)
#pragma unroll
                        for (int j = 0; j < 4; ++j) { const float pv = va[n][j] ? __expf(s[n][mb][j] - mnew) : 0.f; s[n][mb][j] = pv; ps += pv; }
                    lrun[mb] = lrun[mb] * alpha + ps; mrun[mb] = mnew;
#pragma unroll
                    for (int c = 0; c < 8; ++c) o[c][mb] = o[c][mb] * alpha;
                }
                pf[mb][0] = pack_frag(s[0][mb], s[1][mb]); pf[mb][1] = pack_frag(s[2][mb], s[3][mb]);
            }
#pragma unroll
            for (int c = 0; c < 8; ++c)
#pragma unroll
                for (int s2 = 0; s2 < 2; ++s2) { const bf16x8 vf = frag_tr_alt(lds + A_VOFF, KVS, 32 * s2, 16 * c, lane);
#pragma unroll
                    for (int mb = 0; mb < MB; ++mb) o[c][mb] = mma(vf, pf[mb][s2], o[c][mb]); }
            if (SBM) { float rm = fminf(R[0], R[MB - 1]);
                rm = fminf(rm, __shfl_xor(rm, 1)); rm = fminf(rm, __shfl_xor(rm, 2)); rm = fminf(rm, __shfl_xor(rm, 4)); rm = fminf(rm, __shfl_xor(rm, 8));
                if (lane == 0) flag[w] = rm; }
        }
    }
#undef ATT_LOAD
    __syncthreads();
#pragma unroll
    for (int mb = 0; mb < MB; ++mb) {
        const int qi = q0 + 16 * mb + fr;
        const size_t grow = rowbase + (SBM ? (size_t)qi : (size_t)qi * r + p);
        if (SBM) {
            const bf16_t* gp = PJ + pjo(96 + h, grow) + 4 * fq; bf16_t* op = PJ + pjo(h, grow) + 4 * fq;
#pragma unroll
            for (int c = 0; c < 8; ++c) { const u32x2 gw = *(const u32x2*)(gp + 16 * c);
                u32x2 ow; ow.x = cvtpk(o[c][mb][0] * silu_f(bflo(gw.x)), o[c][mb][1] * silu_f(bfhi(gw.x))); ow.y = cvtpk(o[c][mb][2] * silu_f(bflo(gw.y)), o[c][mb][3] * silu_f(bfhi(gw.y)));
                *(u32x2*)(op + 16 * c) = ow; }
        } else {
            float l = lrun[mb]; l += __shfl_xor(l, 16); l += __shfl_xor(l, 32);
            const float inv = 1.0f / l;
            bf16_t* op = OG + ((size_t)(g * 16 + h) * MH + grow) * 128 + 4 * fq;
#pragma unroll
            for (int c = 0; c < 8; ++c) { u32x2 ow; ow.x = cvtpk(o[c][mb][0] * inv, o[c][mb][1] * inv); ow.y = cvtpk(o[c][mb][2] * inv, o[c][mb][3] * inv); *(u32x2*)(op + 16 * c) = ow; }
            if (fq == 0) LSE[(size_t)(g * 16 + h) * MH + grow] = mrun[mb] + __logf(l);
        }
    }
}

__device__ __forceinline__ void attn_phase(LAS unsigned char* lds, bf16_t* PJ, const float* qg, const float* kg, bf16_t* OG, float* LSE) {
    const int wg = blockIdx.x;
    for (int j = 0; j < 2; ++j) {
        for (int pair = wg; pair < 256; pair += gridDim.x) {
            const int bl = pair >> 7, h = (pair >> 3) & 15, qh = pair & 7, qt = j == 0 ? 15 - qh : qh;
            attn_item<true>(lds, PJ, bl, h, qt, 1, 0, 0, qg, kg, OG, LSE);
        }
    }
    for (int id = wg; id < 2 * 16 * 96; id += gridDim.x) {
        const int bh = id / 96, rem = id % 96, bl = bh >> 4, h = bh & 15;
        int g, r, p, n;
        if (rem < 32) { g = 0; r = 1; p = 0; n = rem; }
        else if (rem < 64) { g = 1; r = 4; p = (rem - 32) >> 3; n = (rem - 32) & 7; }
        else { g = 2; r = 16; p = (rem - 64) >> 1; n = (rem - 64) & 1; }
        attn_item<false>(lds, PJ, bl, h, n, r, p, g, qg, kg, OG, LSE);
    }
}
__device__ __forceinline__ void combine_phase(bf16_t* PJ, const bf16_t* OG, const float* LSE) {
    const size_t total = (size_t)16 * MH * 16, stride = (size_t)gridDim.x * 512;
    for (size_t id = (size_t)blockIdx.x * 512 + opaque_tid(); id < total; id += stride) {
        const int ch = (int)(id & 15); const size_t hr = id >> 4; const int h = (int)(hr / MH); const size_t row = hr % MH;
        const float l0 = LSE[hr], l1 = LSE[(size_t)16 * MH + hr], l2 = LSE[(size_t)32 * MH + hr];
        const float mx = fmaxf(l0, fmaxf(l1, l2)); float w0 = __expf(l0 - mx), w1 = __expf(l1 - mx), w2 = __expf(l2 - mx);
        const float inv = 1.0f / (w0 + w1 + w2); w0 *= inv; w1 *= inv; w2 *= inv;
        float a[8], b[8], c[8], gt[8], o[8];
        unpack8(*(const u32x4*)(OG + hr * 128 + 8 * ch), a);
        unpack8(*(const u32x4*)(OG + ((size_t)16 * MH + hr) * 128 + 8 * ch), b);
        unpack8(*(const u32x4*)(OG + ((size_t)32 * MH + hr) * 128 + 8 * ch), c);
        unpack8(*(const u32x4*)(PJ + pjo(112 + h, row) + 8 * ch), gt);
#pragma unroll
        for (int e = 0; e < 8; ++e) o[e] = (w0 * a[e] + w1 * b[e] + w2 * c[e]) * silu_f(gt[e]);
        *(u32x4*)(PJ + pjo(16 + h, row) + 8 * ch) = pack8(o);
    }
}

constexpr int G_CUM = 0, G_QT = 32768, G_KT = G_QT + 64 * KVS, G_VT = G_KT + 64 * KVS, G_SBT = G_VT + 64 * KVS, G_PS = G_SBT + 128 * KVS, G_CM = G_PS + 2048, G_XS = G_CM + 1024, G_END = G_XS + 512;
static_assert(G_END <= 131072, "hgrn lds");
template <bool STATE_ONLY>
__device__ __forceinline__ void hgrn_seg(LAS unsigned char* lds, bf16_t* PJ, const float* og, const float* lbl, float* LST, float* DT, int bl, int h, int seg) {
    const int tid = opaque_tid(), lane = tid & 63, w = __builtin_amdgcn_readfirstlane(tid >> 6), fr = lane & 15, fq = lane >> 4;
    LAS float* CUM = (LAS float*)(lds + G_CUM); LAS float* PS = (LAS float*)(lds + G_PS); LAS float* CM = (LAS float*)(lds + G_CM);
    const int ch = tid & 15, c0 = 8 * ch;
    float lbv[8], oml[8];
#pragma unroll
    for (int e = 0; e < 8; ++e) { const float d = lbl[DI + h * 128 + c0 + e] - lbl[h * 128 + c0 + e]; lbv[e] = 1.0f / (1.0f + __expf(-d)); oml[e] = 1.0f - lbv[e]; }
    f32x4 S[8];
#pragma unroll
    for (int v2 = 0; v2 < 8; ++v2) S[v2] = (f32x4){0.f, 0.f, 0.f, 0.f};
    const size_t rowbase = (size_t)bl * SEQ + (size_t)seg * 1024;
    const int bh = bl * 32 + h;
    f32x4 dsum = (f32x4){0.f, 0.f, 0.f, 0.f};
    if (!STATE_ONLY) {
        for (int i = seg - 1; i >= 0; --i) {
            const float* L = LST + (size_t)(bh * 4 + i) * 16384 + (size_t)(16 * w + 4 * fq) * 128 + fr;
            const f32x4 e = (f32x4){__expf(dsum[0]), __expf(dsum[1]), __expf(dsum[2]), __expf(dsum[3])};
#pragma unroll
            for (int v2 = 0; v2 < 8; ++v2)
#pragma unroll
                for (int j = 0; j < 4; ++j) S[v2][j] += e[j] * L[j * 128 + 16 * v2];
            dsum += *(const f32x4*)(DT + (size_t)(bh * 4 + i) * 128 + 16 * w + 4 * fq);
        }
    }
    const int tb = w >> 1, vh = w & 1;
    LAS float* XS = (LAS float*)(lds + G_XS);
    f32x4 ogv[4];
    if (!STATE_ONLY) {
#pragma unroll
        for (int vbi = 0; vbi < 4; ++vbi) ogv[vbi] = *(const f32x4*)(og + 16 * (4 * vh + vbi) + 4 * fq); }
    u32x4 qn[2], fn[2], vn[2];
#define HG_LOAD(ckx) do { const size_t rr_ = rowbase + (size_t)(ckx) * 64; \
        _Pragma("unroll") for (int i = 0; i < 2; ++i) { const size_t ro_ = rr_ + (tid >> 4) + 32 * i; if (!STATE_ONLY) qn[i] = *(const u32x4*)(PJ + pjo(h, ro_) + c0); \
            fn[i] = *(const u32x4*)(PJ + pjo(32 + h, ro_) + c0); vn[i] = *(const u32x4*)(PJ + pjo(64 + h, ro_) + c0); } } while (0)
    HG_LOAD(0);
    for (int ck = 0; ck < 16; ++ck) {
        const size_t r0 = rowbase + (size_t)ck * 64;
        u32x4 qraw[2], vraw[2]; float kk[2][8];
#pragma unroll
        for (int i = 0; i < 2; ++i) {
            const int t = (tid >> 4) + 32 * i;
            if (!STATE_ONLY) qraw[i] = qn[i];
            vraw[i] = vn[i];
            float fp[8]; unpack8(fn[i], fp);
            float lf[8];
#pragma unroll
            for (int e = 0; e < 8; ++e) { const float sg = 1.0f / (1.0f + __expf(-fp[e])); const float f = lbv[e] + oml[e] * sg; lf[e] = __logf(f); kk[i][e] = oml[e] * (1.0f - sg); }
            *(LAS f32x4*)(CUM + t * 128 + c0) = (f32x4){lf[0], lf[1], lf[2], lf[3]};
            *(LAS f32x4*)(CUM + t * 128 + c0 + 4) = (f32x4){lf[4], lf[5], lf[6], lf[7]};
        }
        if (ck + 1 < 16) HG_LOAD(ck + 1);
        __syncthreads();
        { const int c = tid & 127, qr = tid >> 7; float run[16];
#pragma unroll
            for (int i = 0; i < 16; ++i) run[i] = CUM[(16 * qr + i) * 128 + c];
#pragma unroll
            for (int i = 1; i < 16; ++i) run[i] += run[i - 1];
            PS[qr * 128 + c] = run[15];
            __syncthreads();
            float off = 0.f;
#pragma unroll
            for (int q2 = 0; q2 < 3; ++q2) { const float pv = PS[q2 * 128 + c]; off += (q2 < qr) ? pv : 0.f; }
#pragma unroll
            for (int i = 0; i < 16; ++i) CUM[(16 * qr + i) * 128 + c] = run[i] + off;
            if (qr == 1) CM[c] = run[15] + off;
            if (qr == 3) CM[128 + c] = run[15] + off; }
        __syncthreads();
        { const f32x4 m0 = *(LAS f32x4*)(CM + c0), m1 = *(LAS f32x4*)(CM + c0 + 4);
            const float cm[8] = {m0.x, m0.y, m0.z, m0.w, m1.x, m1.y, m1.z, m1.w};
#pragma unroll
            for (int i = 0; i < 2; ++i) {
                const int t = (tid >> 4) + 32 * i;
                const f32x4 u0 = *(LAS f32x4*)(CUM + t * 128 + c0), u1 = *(LAS f32x4*)(CUM + t * 128 + c0 + 4);
                const float cu[8] = {u0.x, u0.y, u0.z, u0.w, u1.x, u1.y, u1.z, u1.w};
                float kt[8];
                if (!STATE_ONLY) { float q[8], qt[8]; unpack8(qraw[i], q);
#pragma unroll
                    for (int e = 0; e < 8; ++e) { const float d = cu[e] - cm[e]; qt[e] = q[e] * __expf(d); kt[e] = kk[i][e] * __expf(-d); }
                    *(LAS u32x4*)(lds + G_QT + t * KVS + ch * 16) = pack8(qt);
                } else {
#pragma unroll
                    for (int e = 0; e < 8; ++e) kt[e] = kk[i][e] * __expf(cm[e] - cu[e]);
                }
                *(LAS u32x4*)(lds + G_KT + t * KVS + ch * 16) = pack8(kt);
                *(LAS u32x4*)(lds + G_VT + t * KVS + ch * 16) = vraw[i];
            }
            if (!STATE_ONLY) {
                const f32x4 cs = *(LAS f32x4*)(CM + 16 * w + 4 * fq);
                const f32x4 es = (f32x4){__expf(cs.x), __expf(cs.y), __expf(cs.z), __expf(cs.w)};
#pragma unroll
                for (int v2 = 0; v2 < 8; ++v2) { u32x2 sw; sw.x = cvtpk(S[v2][0] * es.x, S[v2][1] * es.y); sw.y = cvtpk(S[v2][2] * es.z, S[v2][3] * es.w);
                    *(LAS u32x2*)(lds + G_SBT + (fr + 16 * v2) * KVS + (16 * w + 4 * fq) * 2) = sw; }
            }
        }
        __syncthreads();
        {
            f32x4 out[4]; u32x2 gt[4];
            if (!STATE_ONLY) {
                const bf16_t* gp = PJ + pjo(96 + h, r0 + 16 * tb + fr) + 64 * vh + 4 * fq;
#pragma unroll
                for (int vbi = 0; vbi < 4; ++vbi) gt[vbi] = *(const u32x2*)(gp + 16 * vbi);
                bf16x8 qtf[4];
#pragma unroll
                for (int ks = 0; ks < 4; ++ks) qtf[ks] = frag_row(lds + G_QT, KVS, 16 * tb, 32 * ks, lane);
#pragma unroll
                for (int vbi = 0; vbi < 4; ++vbi) { out[vbi] = (f32x4){0.f, 0.f, 0.f, 0.f};
#pragma unroll
                    for (int ks = 0; ks < 4; ++ks) out[vbi] = mma(frag_row(lds + G_SBT, KVS, 16 * (4 * vh + vbi), 32 * ks, lane), qtf[ks], out[vbi]); }
                f32x4 at[4];
#pragma unroll
                for (int sb = 0; sb < 4; ++sb) {
                    at[sb] = (f32x4){0.f, 0.f, 0.f, 0.f};
                    if (sb <= tb) {
#pragma unroll
                        for (int ks = 0; ks < 4; ++ks) at[sb] = mma(frag_row(lds + G_KT, KVS, 16 * sb, 32 * ks, lane), qtf[ks], at[sb]);
                        if (sb == tb) {
#pragma unroll
                            for (int j = 0; j < 4; ++j) if (4 * fq + j > fr) at[sb][j] = 0.f;
                        }
                    }
                }
#pragma unroll
                for (int s2 = 0; s2 < 2; ++s2) if (2 * s2 <= tb) { const bf16x8 pf = pack_frag(at[2 * s2], at[2 * s2 + 1]);
#pragma unroll
                    for (int vbi = 0; vbi < 4; ++vbi) out[vbi] = mma(frag_tr_alt(lds + G_VT, KVS, 32 * s2, 16 * (4 * vh + vbi), lane), pf, out[vbi]); }
                float ss = 0.f;
#pragma unroll
                for (int vbi = 0; vbi < 4; ++vbi) ss += (out[vbi][0] * out[vbi][0] + out[vbi][1] * out[vbi][1]) + (out[vbi][2] * out[vbi][2] + out[vbi][3] * out[vbi][3]);
                ss += __shfl_xor(ss, 16); ss += __shfl_xor(ss, 32);
                if (fq == 0) XS[(2 * tb + vh) * 16 + fr] = ss;
            }
            const f32x4 cl = *(LAS f32x4*)(CM + 128 + 16 * w + 4 * fq), cmm = *(LAS f32x4*)(CM + 16 * w + 4 * fq);
            const f32x4 e1 = (f32x4){__expf(cl[0]), __expf(cl[1]), __expf(cl[2]), __expf(cl[3])};
            const f32x4 e2 = (f32x4){__expf(cl[0] - cmm[0]), __expf(cl[1] - cmm[1]), __expf(cl[2] - cmm[2]), __expf(cl[3] - cmm[3])};
            if (STATE_ONLY) dsum += cl;
            const bf16x8 kf0 = frag_tr(lds + G_KT, KVS, 0, 16 * w, lane), kf1 = frag_tr(lds + G_KT, KVS, 32, 16 * w, lane);
#pragma unroll
            for (int v2 = 0; v2 < 8; ++v2) {
                f32x4 U = (f32x4){0.f, 0.f, 0.f, 0.f};
                U = mma(kf0, frag_tr(lds + G_VT, KVS, 0, 16 * v2, lane), U);
                U = mma(kf1, frag_tr(lds + G_VT, KVS, 32, 16 * v2, lane), U);
                S[v2] = e1 * S[v2] + e2 * U;
            }
            if (!STATE_ONLY) {
                __syncthreads();
                const float rs = rsqrtf((XS[(2 * tb) * 16 + fr] + XS[(2 * tb + 1) * 16 + fr]) * (1.f / 128.f) + RMS_EPS);
                bf16_t* op = PJ + pjo(h, r0 + 16 * tb + fr) + 64 * vh + 4 * fq;
#pragma unroll
                for (int vbi = 0; vbi < 4; ++vbi) { u32x2 ow;
                    ow.x = cvtpk(out[vbi][0] * rs * ogv[vbi][0] * silu_f(bflo(gt[vbi].x)), out[vbi][1] * rs * ogv[vbi][1] * silu_f(bfhi(gt[vbi].x)));
                    ow.y = cvtpk(out[vbi][2] * rs * ogv[vbi][2] * silu_f(bflo(gt[vbi].y)), out[vbi][3] * rs * ogv[vbi][3] * silu_f(bfhi(gt[vbi].y)));
                    *(u32x2*)(op + 16 * vbi) = ow; }
            }
        }
    }
#undef HG_LOAD
    if (STATE_ONLY) {
        float* L = LST + (size_t)(bh * 4 + seg) * 16384 + (size_t)(16 * w + 4 * fq) * 128 + fr;
#pragma unroll
        for (int v2 = 0; v2 < 8; ++v2)
#pragma unroll
            for (int j = 0; j < 4; ++j) L[j * 128 + 16 * v2] = S[v2][j];
        if (fr == 0) *(f32x4*)(DT + (size_t)(bh * 4 + seg) * 128 + 16 * w + 4 * fq) = dsum;
    }
    __syncthreads();
}
__device__ __forceinline__ void hgrn_post(bf16_t* PJ, const bf16_t* O1, const float* og) {
    const size_t total = (size_t)32 * MH * 16, stride = (size_t)gridDim.x * 512;
    const int tid = opaque_tid(); const int ch = tid & 15;
    const f32x4 g0 = *(const f32x4*)(og + 8 * ch), g1 = *(const f32x4*)(og + 8 * ch + 4);
    const float gg[8] = {g0.x, g0.y, g0.z, g0.w, g1.x, g1.y, g1.z, g1.w};
    for (size_t id = (size_t)blockIdx.x * 512 + tid; id < total; id += stride) {
        const size_t hr = id >> 4; const int h = (int)(hr / MH); const size_t row = hr % MH;
        float o[8], gt[8]; unpack8(*(const u32x4*)(O1 + hr * 128 + 8 * ch), o); unpack8(*(const u32x4*)(PJ + pjo(96 + h, row) + 8 * ch), gt);
        float ss = 0.f;
#pragma unroll
        for (int e = 0; e < 8; ++e) ss += o[e] * o[e];
        ss += __shfl_xor(ss, 1); ss += __shfl_xor(ss, 2); ss += __shfl_xor(ss, 4); ss += __shfl_xor(ss, 8);
        const float rs = rsqrtf(ss * (1.f / 128.f) + RMS_EPS);
#pragma unroll
        for (int e = 0; e < 8; ++e) o[e] = o[e] * rs * gg[e] * silu_f(gt[e]);
        *(u32x4*)(PJ + pjo(h, row) + 8 * ch) = pack8(o);
    }
}


#define XB_TMO      128
#define XB_XCNT(j)  (256  + 64 * (j))
#define XB_XSUB(j)  (1280 + 64 * (j))
#define XB_XGEN(j)  (2304 + 64 * (j))
#define XB_TOP      3328
#define XB_TOPGEN   3392
#define XCD_BAR_WORDS 3456
#define XB_SPIN_CAP (1u << 20)
__device__ __forceinline__ unsigned xb_ld(unsigned* p)              { return __hip_atomic_load(p, __ATOMIC_RELAXED, __HIP_MEMORY_SCOPE_AGENT); }
__device__ __forceinline__ unsigned xb_add(unsigned* p, unsigned v) { return __hip_atomic_fetch_add(p, v, __ATOMIC_RELAXED, __HIP_MEMORY_SCOPE_AGENT); }
__device__ __forceinline__ unsigned xb_xcc_id() { return (unsigned)__builtin_amdgcn_s_getreg((3 << 11) | 20) & 0xFu; }
#define XB_SPIN(cond, bar) do { unsigned _sp = 0; while (cond) { __builtin_amdgcn_s_sleep(1); \
    if ((++_sp & 255u) == 0u) { if (xb_ld(&(bar)[XB_TMO])) break; if (_sp > XB_SPIN_CAP) { atomicAdd(&(bar)[XB_TMO], 1u); break; } } } } while (0)
struct XcdBarrier { unsigned* bar; unsigned x; volatile LAS unsigned* st; };
__device__ __forceinline__ XcdBarrier xcd_barrier_post(unsigned* bar, volatile LAS unsigned* st) {
    XcdBarrier b; b.bar = bar; b.x = xb_xcc_id(); b.st = st;
    if (threadIdx.x == 0) (void)xb_add(&bar[XB_XCNT(b.x)], 1u);
    return b;
}
__device__ __forceinline__ void xcd_barrier_complete(unsigned* bar, unsigned x, unsigned& nloc, unsigned& nx) {
    const unsigned G = gridDim.x * gridDim.y * gridDim.z;
    unsigned sum, cnt, mine, sp = 0u;
    for (;;) {
        sum = 0u; cnt = 0u; mine = 0u;
#pragma unroll
        for (unsigned j = 0; j < 16; ++j) { const unsigned c = xb_ld(&bar[XB_XCNT(j)]); sum += c; cnt += (c > 0u) ? 1u : 0u; mine = (j == x) ? c : mine; }
        if (sum == G) break;
        __builtin_amdgcn_s_sleep(1);
        if ((++sp & 255u) == 0u) { if (xb_ld(&bar[XB_TMO])) break; if (sp > XB_SPIN_CAP) { atomicAdd(&bar[XB_TMO], 1u); break; } }
    }
    nloc = mine > 0u ? mine : 1u; nx = cnt > 0u ? cnt : 1u;
}
__device__ __forceinline__ void xcd_barrier(const XcdBarrier& b) {
    asm volatile("s_waitcnt vmcnt(0)" ::: "memory");
    __syncthreads();
    if (threadIdx.x == 0) {
        unsigned* bar = b.bar;
        __builtin_amdgcn_s_waitcnt(0);
        unsigned nloc = b.st[0], nx = b.st[1];
        if (nloc == 0u) { xcd_barrier_complete(bar, b.x, nloc, nx); b.st[0] = nloc; b.st[1] = nx; }
        const unsigned old = xb_add(&bar[XB_XSUB(b.x)], 1u);
        const unsigned gen = old / nloc;
        if (old + 1u == (gen + 1u) * nloc) {
            __builtin_amdgcn_fence(__ATOMIC_RELEASE, "agent");
            asm volatile("s_waitcnt vmcnt(0)" ::: "memory");
            const unsigned og = xb_add(&bar[XB_TOP], 1u);
            const unsigned tg = og / nx;
            if (og + 1u == (tg + 1u) * nx) xb_add(&bar[XB_TOPGEN], 1u);
            else XB_SPIN(xb_ld(&bar[XB_TOPGEN]) == tg, bar);
            __builtin_amdgcn_fence(__ATOMIC_ACQUIRE, "agent");
            xb_add(&bar[XB_XGEN(b.x)], 1u);
            asm volatile("s_waitcnt vmcnt(0)" ::: "memory");
        } else {
            XB_SPIN(xb_ld(&bar[XB_XGEN(b.x)]) == gen, bar);
            __builtin_amdgcn_fence(__ATOMIC_ACQUIRE, "agent");
            asm volatile("s_waitcnt vmcnt(0)" ::: "memory");
        }
    }
    __syncthreads();
}

struct Args { const float* in[11]; float* out; unsigned char* ws; unsigned long long pad; };

__global__ void __launch_bounds__(512, 2) fwd(Args a) {
    extern __shared__ __attribute__((aligned(16))) unsigned char lds_raw[];
    LAS unsigned char* lds = (LAS unsigned char*)lds_raw;
    cg::grid_group grid = cg::this_grid();
    const float* x = a.in[0]; const float* norm_even = a.in[1]; const float* w_in_even = a.in[2]; const float* qg = a.in[3]; const float* kg = a.in[4];
    const float* w_out_even = a.in[5]; const float* norm_odd = a.in[6]; const float* w_in_odd = a.in[7]; const float* lbl = a.in[8]; const float* og = a.in[9]; const float* w_out_odd = a.in[10];
    bf16_t* WinT = (bf16_t*)(a.ws + WS_WIN); bf16_t* WoT = (bf16_t*)(a.ws + WS_WO); bf16_t* XN = (bf16_t*)(a.ws + WS_XN); bf16_t* PJ = (bf16_t*)(a.ws + WS_PJ);
    bf16_t* OG = (bf16_t*)(a.ws + WS_OG); float* LSE = (float*)(a.ws + WS_LSE);
    float* LST = (float*)(a.ws + WS_OG + 64 * MiB); float* DTOT = (float*)(a.ws + WS_OG + 80 * MiB);
    float* out = a.out;
    volatile LAS unsigned* bst = (volatile LAS unsigned*)(lds + LDS_BYTES - 64);
    if (threadIdx.x < 2) bst[threadIdx.x] = 0u;
    __syncthreads();
    const XcdBarrier xbar = xcd_barrier_post((unsigned*)a.ws, bst);
#define GSYNC() xcd_barrier(xbar)

#ifdef PROBE_SEL
    unsigned long long tprev = __builtin_amdgcn_s_memrealtime(), tacc = 0ull;
#define STAMP(kind) do { const unsigned long long now_ = __builtin_amdgcn_s_memrealtime(); if ((PROBE_SEL >> ((kind) + 8 * layer)) & 1) tacc += now_ - tprev; tprev = now_; } while (0)
#else
#define STAMP(kind) do { } while (0)
#endif
    for (int layer = 0; layer < 2; ++layer) {
        prologue(lds, layer == 0 ? x : out, layer == 0 ? norm_even : norm_odd, layer == 0 ? w_in_even : w_in_odd, layer == 0 ? w_out_even : w_out_odd, WinT, WoT, XN);
        if (layer == 0) grid.sync(); else GSYNC();
        STAMP(0);
        for (int half = 0; half < 2; ++half) {
            { pg8::Gemm g{XN + (size_t)half * MH * DM, WinT, MH, NC, DM, DM, 5, 0}; pg8::StaticOrder S; S.init(MH, NC, gridDim.x, blockIdx.x);
              pg8::EpiBf16 E{PJ, NC}; pg8::gemm_phase<pg8::EpiBf16>(lds, g, S, E); }
            GSYNC(); STAMP(1);
            if (layer == 0) {
                attn_phase(lds, PJ, qg, kg, OG, LSE);
                GSYNC(); STAMP(2);
                combine_phase(PJ, OG, LSE);
            } else {
                for (int it = blockIdx.x; it < 256; it += gridDim.x) { if ((it & 3) < 3) hgrn_seg<true>(lds, PJ, og, lbl, LST, DTOT, it >> 7, (it >> 2) & 31, it & 3); }
                GSYNC();
                for (int it = blockIdx.x; it < 256; it += gridDim.x) hgrn_seg<false>(lds, PJ, og, lbl, LST, DTOT, it >> 7, (it >> 2) & 31, it & 3);
            }
            GSYNC(); STAMP(3);
            { pg8::Gemm g{PJ, WoT, MH, DM, DI, 128, 1, (size_t)MH * 256}; pg8::StaticOrder S; S.init(MH, DM, gridDim.x, blockIdx.x);
              const float* res = (layer == 0 ? x : out) + (size_t)half * MH * DM;
              pg8::EpiRes E{res, out + (size_t)half * MH * DM, DM}; pg8::gemm_phase<pg8::EpiRes>(lds, g, S, E); }
            if (layer == 0 || half == 0) GSYNC();
            STAMP(4);
        }
    }
#ifdef PROBE_SEL
    if (blockIdx.x == 0) { const int K = (int)(tacc / 100ull); for (int i = threadIdx.x; i < K; i += 512) out[i] += 0.125f; }
#endif
}

extern "C" void kernel_launch(void* const* d_in, const int* in_sizes, int n_in, void* d_out, int out_size, void* d_ws, size_t ws_size, hipStream_t stream) {
    static int grid = 0;
    if (grid == 0) {
        if (n_in != 11 || out_size != MTOK * DM || ws_size < WS_END) { fprintf(stderr, "kernel_launch: unexpected shapes (n_in %d out %d ws %zu)\n", n_in, out_size, ws_size); grid = -1; return; }
        int dev = 0, cus = 0, per_cu = 0;
        (void)hipGetDevice(&dev);
        (void)hipDeviceGetAttribute(&cus, hipDeviceAttributeMultiprocessorCount, dev);
        (void)hipFuncSetAttribute((const void*)fwd, hipFuncAttributeMaxDynamicSharedMemorySize, LDS_BYTES);
        (void)hipOccupancyMaxActiveBlocksPerMultiprocessor(&per_cu, (const void*)fwd, 512, LDS_BYTES);
        (void)hipGetLastError();
        grid = cus > 0 ? cus : 256;
    }
    if (grid < 0) return;
    (void)hipMemsetAsync(d_ws, 0, 16384, stream);
    Args a{};
    for (int i = 0; i < 11; ++i) a.in[i] = (const float*)d_in[i];
    a.out = (float*)d_out; a.ws = (unsigned char*)d_ws;
    void* args[] = {&a};
    hipError_t e = hipLaunchCooperativeKernel((const void*)fwd, dim3(grid), dim3(512), args, LDS_BYTES, stream);
    if (e != hipSuccess) fprintf(stderr, "cooperative launch failed: %s\n", hipGetErrorString(e));
}
```
